# Optimizing an MI355X kernel written in HIP

```python
import math
import jax, jax.numpy as jnp
from jax import lax
import numpy as np

D_MODEL = 2048
BATCH = 16
SEQ = 256
DEPTH = 2
DEC_BATCH = 2
DEC_SEQ = 1024
PAST_LEN = 256

GRID_W = 64
N_MIXERS = 2
N_ATTN_LAYERS = (DEPTH + 1) // 2
N_SSM_LAYERS = DEPTH // 2
N_HEADS = 16
QK_NOPE = 128
QK_ROPE = 64
V_HEAD = 128
Q_LORA = 768
KV_LORA = 512
ROPE_THETA = 10000.0
Q_BLOCK = 128
ATTN_SCALE = (QK_NOPE + QK_ROPE) ** -0.5
S5_GROUP = 16
S5_GROUPS = D_MODEL // S5_GROUP
S5_STATE = 64
S5_DT_MIN = 1e-3
S5_DT_MAX = 1e-1
D_FF = 5632
N_SUB = 3
EPS = 1e-6

kernel_name = "hybrid_mla_s5_macaron_dit_step"

F32 = jnp.float32


def rms_norm(x, g):
    xf = x.astype(F32)
    y = xf * lax.rsqrt(jnp.mean(xf * xf, axis=-1, keepdims=True) + EPS)
    return (y * g.astype(F32)).astype(x.dtype)


def modulate(h, shift, scale):
    return h * (1 + scale) + shift


def swiglu(h, w_in, w_out):
    g, u = jnp.split(h @ w_in, 2, axis=-1)
    return (jax.nn.silu(g) * u) @ w_out


def axial_rope_tables(length):
    rows = length // GRID_W
    row = jnp.repeat(jnp.arange(rows), GRID_W).astype(F32)
    col = jnp.tile(jnp.arange(GRID_W), rows).astype(F32)
    half = QK_ROPE // 2
    inv_freq = ROPE_THETA ** (-jnp.arange(0, half, 2, dtype=F32) / half)
    ang_r = row[:, None] * inv_freq
    ang_c = col[:, None] * inv_freq
    ang = jnp.concatenate([ang_r, ang_r, ang_c, ang_c], axis=-1)
    return jnp.cos(ang), jnp.sin(ang)


def _rot_half(z):
    z1, z2 = jnp.split(z, 2, axis=-1)
    return jnp.concatenate([-z2, z1], axis=-1)


def apply_axial_rope(x, cos, sin):
    xr, xc = jnp.split(x, 2, axis=-1)
    xrot = jnp.concatenate([_rot_half(xr), _rot_half(xc)], axis=-1)
    return (x.astype(F32) * cos + xrot.astype(F32) * sin).astype(x.dtype)


def mla_queries(h, w_dq, q_norm, w_uq):
    b, l, _ = h.shape
    cq = rms_norm(h @ w_dq, q_norm)
    q = (cq @ w_uq).reshape(b, l, N_HEADS, QK_NOPE + QK_ROPE)
    return q[..., :QK_NOPE], q[..., QK_NOPE:]


def mla_compress_kv(h, w_dkv, kv_norm):
    kv = h @ w_dkv
    return rms_norm(kv[..., :KV_LORA], kv_norm), kv[..., KV_LORA:]


def mla_expand(ckv, w_ukv):
    b, l, _ = ckv.shape
    kv = (ckv @ w_ukv).reshape(b, l, N_HEADS, QK_NOPE + V_HEAD)
    return kv[..., :QK_NOPE], kv[..., QK_NOPE:]


def attend(q_nope, q_pe, k_nope, k_pe, v):
    b, lq, h, _ = q_nope.shape
    nb = lq // Q_BLOCK

    def block(args):
        qn, qp = args
        s = jnp.einsum('bqhd,bkhd->bhqk', qn, k_nope) + jnp.einsum('bqhd,bkd->bhqk', qp, k_pe)
        p = jax.nn.softmax(s.astype(F32) * ATTN_SCALE, axis=-1).astype(v.dtype)
        return jnp.einsum('bhqk,bkhd->bqhd', p, v)

    qn_b = jnp.moveaxis(q_nope.reshape(b, nb, Q_BLOCK, h, QK_NOPE), 1, 0)
    qp_b = jnp.moveaxis(q_pe.reshape(b, nb, Q_BLOCK, h, QK_ROPE), 1, 0)
    out = lax.map(block, (qn_b, qp_b))
    return jnp.moveaxis(out, 0, 1).reshape(b, lq, h * V_HEAD)


def mla_context(h, w_dq, q_norm, w_uq, w_dkv, kv_norm, w_ukv, w_o):
    q_nope, q_pe = mla_queries(h, w_dq, q_norm, w_uq)
    ckv, kpe = mla_compress_kv(h, w_dkv, kv_norm)
    k_nope, v = mla_expand(ckv, w_ukv)
    o = attend(q_nope, q_pe, k_nope, kpe, v)
    return o @ w_o, (ckv, kpe)


def mla_latent(h, ckv_ctx, kpe_ctx, w_dq, q_norm, w_uq, w_dkv, kv_norm, w_ukv, w_o):
    cos, sin = axial_rope_tables(h.shape[1])
    q_nope, q_pe = mla_queries(h, w_dq, q_norm, w_uq)
    q_pe = apply_axial_rope(q_pe, cos[:, None, :], sin[:, None, :])
    ckv, kpe = mla_compress_kv(h, w_dkv, kv_norm)
    kpe = apply_axial_rope(kpe, cos, sin)
    ckv_all = jnp.concatenate([ckv_ctx, ckv], axis=1)
    kpe_all = jnp.concatenate([kpe_ctx, kpe], axis=1)
    k_nope, v = mla_expand(ckv_all, w_ukv)
    o = attend(q_nope, q_pe, k_nope, kpe_all, v)
    return o @ w_o, None


def s5_discretize(a_re, a_im, log_dt, b_re, b_im):
    lam = lax.complex(a_re.astype(F32), a_im.astype(F32))
    dt = jnp.exp(log_dt.astype(F32))[:, None]
    abar = jnp.exp(lam * dt)
    bmat = lax.complex(b_re.astype(F32), b_im.astype(F32))
    bbar = ((abar - 1) / lam)[..., None] * bmat
    return abar, bbar


def _linear_combine(e1, e2):
    a1, b1 = e1
    a2, b2 = e2
    return a1 * a2, a2 * b1 + b2


def s5_scan(u, abar, bbar, cmat, h0, reverse):
    bu = jnp.einsum('blgk,gpk->blgp', u.astype(jnp.complex64), bbar)
    a = jnp.broadcast_to(abar, bu.shape)
    a_cum, hs = lax.associative_scan(_linear_combine, (a, bu), axis=1, reverse=reverse)
    if h0 is not None:
        hs = hs + a_cum * h0[:, None]
    y = jnp.real(jnp.einsum('gkp,blgp->blgk', cmat, hs))
    h_last = hs[:, 0] if reverse else hs[:, -1]
    return y, h_last


def s5_mixer(h, h0_re, h0_im, a_re, a_im, log_dt, b_re, b_im, c_re, c_im, d, w_glu):
    b, l, _ = h.shape
    hf = h.astype(F32)
    u = hf.reshape(b, l, S5_GROUPS, S5_GROUP)
    y = d.astype(F32) * hf
    finals = []
    for direction in range(2):
        abar, bbar = s5_discretize(a_re[direction], a_im[direction], log_dt[direction],
                                   b_re[direction], b_im[direction])
        cmat = lax.complex(c_re[direction].astype(F32), c_im[direction].astype(F32))
        h0 = None if h0_re is None else lax.complex(h0_re[:, direction].astype(F32),
                                                    h0_im[:, direction].astype(F32))
        y_dir, h_last = s5_scan(u, abar, bbar, cmat, h0, reverse=(direction == 1))
        y = y + y_dir.reshape(b, l, D_MODEL)
        finals.append(h_last)
    g = jax.nn.gelu(y).astype(h.dtype)
    ga, gb = jnp.split(g @ w_glu, 2, axis=-1)
    out = ga * jax.nn.sigmoid(gb)
    if h0_re is not None:
        return out, None
    hs = jnp.stack(finals, axis=1)
    return out, (jnp.real(hs).astype(h.dtype), jnp.imag(hs).astype(h.dtype))


def setup_inputs(seed: int = 0) -> dict:
    key = jax.random.key(seed)
    ks = iter(jax.random.split(key, 40))

    def nrm(shape, scale):
        return jax.random.normal(next(ks), shape, F32) * scale

    na, ns, g, p = N_ATTN_LAYERS, N_SSM_LAYERS, S5_GROUPS, S5_STATE
    a_im_base = math.pi * jnp.arange(p, dtype=F32)
    lo, hi = math.log(S5_DT_MIN), math.log(S5_DT_MAX)
    return {
        "x_prompt": nrm((BATCH, SEQ, D_MODEL), 1.0),
        "x_sample": nrm((DEC_BATCH, DEC_SEQ, D_MODEL), 1.0),
        "cache_ckv": nrm((DEC_BATCH, na, PAST_LEN, KV_LORA), 1.0),
        "cache_kpe": nrm((DEC_BATCH, na, PAST_LEN, QK_ROPE), 1.0),
        "state_ssm_re": nrm((DEC_BATCH, ns, 2, g, p), 0.1),
        "state_ssm_im": nrm((DEC_BATCH, ns, 2, g, p), 0.1),
        "c": nrm((DEC_BATCH, D_MODEL), 1.0),
        "c_ctx": nrm((D_MODEL,), 1.0),
        "mod_w": nrm((DEPTH, D_MODEL, N_SUB * 3 * D_MODEL), 0.5 * D_MODEL ** -0.5),
        "mod_b": nrm((DEPTH, N_SUB * 3 * D_MODEL), 0.02),
        "norm_g": 1.0 + nrm((DEPTH, N_SUB, D_MODEL), 0.02),
        "ffn_w_in": nrm((DEPTH, 2, D_MODEL, 2 * D_FF), D_MODEL ** -0.5),
        "ffn_w_out": nrm((DEPTH, 2, D_FF, D_MODEL), D_FF ** -0.5),
        "mla_w_dq": nrm((na, D_MODEL, Q_LORA), D_MODEL ** -0.5),
        "mla_q_norm": 1.0 + nrm((na, Q_LORA), 0.02),
        "mla_w_uq": nrm((na, Q_LORA, N_HEADS * (QK_NOPE + QK_ROPE)), Q_LORA ** -0.5),
        "mla_w_dkv": nrm((na, D_MODEL, KV_LORA + QK_ROPE), D_MODEL ** -0.5),
        "mla_kv_norm": 1.0 + nrm((na, KV_LORA), 0.02),
        "mla_w_ukv": nrm((na, KV_LORA, N_HEADS * (QK_NOPE + V_HEAD)), KV_LORA ** -0.5),
        "mla_w_o": nrm((na, N_HEADS * V_HEAD, D_MODEL), (N_HEADS * V_HEAD) ** -0.5),
        "s5_a_re": -0.5 + nrm((ns, 2, g, p), 0.01),
        "s5_a_im": a_im_base + nrm((ns, 2, g, p), 0.01),
        "s5_log_dt": jax.random.uniform(next(ks), (ns, 2, g), F32, lo, hi),
        "s5_b_re": nrm((ns, 2, g, p, S5_GROUP), (2 * S5_GROUP) ** -0.5),
        "s5_b_im": nrm((ns, 2, g, p, S5_GROUP), (2 * S5_GROUP) ** -0.5),
        "s5_c_re": nrm((ns, 2, g, S5_GROUP, p), p ** -0.5),
        "s5_c_im": nrm((ns, 2, g, S5_GROUP, p), p ** -0.5),
        "s5_d": nrm((ns, D_MODEL), 1.0),
        "s5_w_glu": nrm((ns, D_MODEL, 2 * D_MODEL), D_MODEL ** -0.5),
        "final_g": 1.0 + nrm((D_MODEL,), 0.02),
    }


def reference(x_prompt, x_sample, cache_ckv, cache_kpe, state_ssm_re, state_ssm_im, c, c_ctx,
              mod_w, mod_b, norm_g, ffn_w_in, ffn_w_out,
              mla_w_dq, mla_q_norm, mla_w_uq, mla_w_dkv, mla_kv_norm, mla_w_ukv, mla_w_o,
              s5_a_re, s5_a_im, s5_log_dt, s5_b_re, s5_b_im, s5_c_re, s5_c_im, s5_d, s5_w_glu,
              final_g):

    def mods_for(cond, l):
        m = jax.nn.silu(cond) @ mod_w[l] + mod_b[l]
        return m.reshape(-1, N_SUB, 3, 1, D_MODEL)

    def layer(x, m, l, mixer):
        h = modulate(rms_norm(x, norm_g[l, 0]), m[:, 0, 0], m[:, 0, 1])
        x = x + 0.5 * m[:, 0, 2] * swiglu(h, ffn_w_in[l, 0], ffn_w_out[l, 0])
        h = modulate(rms_norm(x, norm_g[l, 1]), m[:, 1, 0], m[:, 1, 1])
        out, aux = mixer(h)
        x = x + m[:, 1, 2] * out
        h = modulate(rms_norm(x, norm_g[l, 2]), m[:, 2, 0], m[:, 2, 1])
        x = x + 0.5 * m[:, 2, 2] * swiglu(h, ffn_w_in[l, 1], ffn_w_out[l, 1])
        return x, aux

    def mla_p(j):
        return (mla_w_dq[j], mla_q_norm[j], mla_w_uq[j], mla_w_dkv[j], mla_kv_norm[j],
                mla_w_ukv[j], mla_w_o[j])

    def s5_p(j):
        return (s5_a_re[j], s5_a_im[j], s5_log_dt[j], s5_b_re[j], s5_b_im[j],
                s5_c_re[j], s5_c_im[j], s5_d[j], s5_w_glu[j])

    x = x_prompt
    ckvs, kpes, s_res, s_ims = [], [], [], []
    for l in range(DEPTH):
        m = mods_for(c_ctx[None], l)
        j = l // N_MIXERS
        if l % N_MIXERS == 0:
            x, (ckv, kpe) = layer(x, m, l, lambda h: mla_context(h, *mla_p(j)))
            ckvs.append(ckv)
            kpes.append(kpe)
        else:
            x, (s_re, s_im) = layer(x, m, l, lambda h: s5_mixer(h, None, None, *s5_p(j)))
            s_res.append(s_re)
            s_ims.append(s_im)
    y_prompt = rms_norm(x, final_g)
    new_ckv = jnp.stack(ckvs, axis=1)
    new_kpe = jnp.stack(kpes, axis=1)
    new_state_re = jnp.stack(s_res, axis=1)
    new_state_im = jnp.stack(s_ims, axis=1)

    x = x_sample
    for l in range(DEPTH):
        m = mods_for(c, l)
        j = l // N_MIXERS
        if l % N_MIXERS == 0:
            x, _ = layer(x, m, l, lambda h: mla_latent(h, cache_ckv[:, j], cache_kpe[:, j], *mla_p(j)))
        else:
            x, _ = layer(x, m, l, lambda h: s5_mixer(h, state_ssm_re[:, j], state_ssm_im[:, j], *s5_p(j)))
    y_sample = rms_norm(x, final_g)

    return (y_prompt, y_sample, new_ckv, new_kpe, new_state_re, new_state_im)
```

```cpp
#include <hip/hip_runtime.h>
#include <cstdio>
#include <cstdint>

#ifndef MK_PER_PHASE
#define MK_PER_PHASE 0
#endif

#define LAS __attribute__((address_space(3)))
#define GAS __attribute__((address_space(1)))
typedef unsigned short bf16_t;
typedef short bf16x8 __attribute__((ext_vector_type(8)));
typedef short bf16x4 __attribute__((ext_vector_type(4)));
typedef float f32x4 __attribute__((ext_vector_type(4)));
typedef float f32x2 __attribute__((ext_vector_type(2)));
typedef float f32x16 __attribute__((ext_vector_type(16)));
typedef unsigned u32x4 __attribute__((ext_vector_type(4)));
typedef unsigned u32x2 __attribute__((ext_vector_type(2)));

constexpr int D = 2048, MT = 6144, MCTX = 4096, DFF = 5632, NFF2 = 11264, NMOD = 18432;
constexpr int KVR = 6656;
constexpr int NQ = 3072, NA = 1536, QL = 768, KVL = 512;
constexpr float EPS = 1e-6f;
constexpr float QSCALE = 0.07216878364870322f * 1.4426950408889634f;

constexpr size_t MiB = 1u << 20;
constexpr size_t WS_CTL = 0, CTL_ZERO_BYTES = 64 * 1024;
constexpr size_t WS_MODS = 1 * MiB;
constexpr size_t WS_ROPE = 2 * MiB;
constexpr size_t WS_WIN = 16 * MiB;
constexpr size_t WS_WOUT = 192 * MiB;
constexpr size_t WS_WA = 280 * MiB;
constexpr size_t WS_WUQ = 286 * MiB;
constexpr size_t WS_WUK = 291 * MiB;
constexpr size_t WS_WUV = 293 * MiB;
constexpr size_t WS_WO = 295 * MiB;
constexpr size_t WS_WGLU = 303 * MiB;
constexpr size_t WS_X = 320 * MiB;
constexpr size_t WS_H = 368 * MiB;
constexpr size_t WS_ACT = 392 * MiB;
constexpr size_t WS_CQKV = 458 * MiB;
constexpr size_t WS_CQ = 494 * MiB;
constexpr size_t WS_CKV = 503 * MiB;
constexpr size_t WS_KPE = 510 * MiB;
constexpr size_t WS_Q = 511 * MiB;
constexpr size_t WS_KN = 547 * MiB;
constexpr size_t WS_VT = 573 * MiB;
constexpr size_t WS_O = 599 * MiB;
constexpr size_t WS_YST = 623 * MiB;
constexpr size_t WS_G = 671 * MiB;
constexpr size_t WS_END = 696 * MiB;

constexpr size_t OUT_Y = 0, OUT_CKV = 12582912, OUT_KPE = 14680064, OUT_SRE = 14942208, OUT_SIM = 15204352;

constexpr int LDS_BYTES = 147456;
constexpr int MISC_OFF = 131072 + 320;

typedef __bf16 bf16x2_t __attribute__((ext_vector_type(2)));
__device__ __forceinline__ unsigned cvt_pk_bf16(float lo, float hi) { const f32x2 v = {lo, hi}; const bf16x2_t b = __builtin_convertvector(v, bf16x2_t); return __builtin_bit_cast(unsigned, b); }
__device__ __forceinline__ float wave_sum(float v) {
#pragma unroll
    for (int o = 1; o < 64; o <<= 1) v += __shfl_xor(v, o);
    return v;
}
__device__ __forceinline__ float silu_f(float v) { return v * __builtin_amdgcn_rcpf(1.0f + __expf(-v)); }
__device__ __forceinline__ float sigmoid_f(float v) { return __builtin_amdgcn_rcpf(1.0f + __expf(-v)); }
__device__ __forceinline__ float gelu_tanh_f(float x) {
    const float z = 0.7978845608028654f * (x + 0.044715f * x * x * x);
    return x * __builtin_amdgcn_rcpf(1.0f + __expf(-2.0f * z));
}
__device__ __forceinline__ int tile_ms(int pm) { return pm < 16 ? 0 : 1 + ((pm - 16) >> 2); }

namespace pg8 {
constexpr int BM = 256, BK = 64, HALF = 128, HTB = HALF * BK * 2, STAGE_BYTES = 8 * HTB, NXCD = 8, WGM = 8;
__host__ __device__ __forceinline__ int lds_byte(int r, int c) { const int st = (r >> 4) * 2 + (c >> 5), rr = r & 15, cc = c & 31, ob = rr * 64 + cc * 2; return st * 1024 + (ob ^ (((ob >> 9) & 1) << 5)); }
__host__ __device__ __forceinline__ void stage_rc(int b, int& R, int& C) { const int st = b / 1024, sb = b % 1024, swz = sb ^ (((sb >> 9) & 1) << 5); R = (st >> 1) * 16 + swz / 64; C = (st & 1) * 32 + (swz % 64) / 2; }
__host__ __device__ __forceinline__ int perm32(int rho) { const int n = rho >> 4, i = rho & 15; return 8 * (i >> 2) + 4 * n + (i & 3); }

struct Unit { int pm, pn; };
struct Gemm { const bf16_t* A; const bf16_t* Bt; int M, N, K; };

struct StaticOrder {
    int nM, nN, nwg, G, c;
    __host__ __device__ void init(int M, int N, int G_, int c_, int rows = BM) { nM = M / rows; nN = N / BM; nwg = nM * nN; G = G_; c = c_; }
    __host__ __device__ bool next(int i, Unit& u) const {
        const long L = (long)i * G + c; if (L >= nwg) return false;
        int wgid = (int)L; { const int q = nwg / NXCD, r = nwg % NXCD, xcd = wgid % NXCD, off = wgid / NXCD; wgid = (xcd < r ? xcd * (q + 1) : r * (q + 1) + (xcd - r) * q) + off; }
        const int nig = WGM * nN, gid = wgid / nig, fm = gid * WGM, gsz = (nM - fm) < WGM ? (nM - fm) : WGM;
        u.pm = fm + ((wgid % nig) % gsz); u.pn = (wgid % nig) / gsz; return true;
    }
    __device__ __forceinline__ void a_ready(const Unit&) const {}
    __device__ __forceinline__ void done(const Unit&) const {}
};

struct FfnMainOrder {
    int G, c;
    __device__ bool next(int i, Unit& u) const {
        const int L = i * G + c; if (L >= 1024) return false;
        const int w0 = (L % NXCD) * 128 + L / NXCD;
        if (w0 < 704) { const int gid = w0 / 352, w = w0 % 352; u.pm = 8 * gid + (w & 7); u.pn = w >> 3; }
        else { const int w = w0 - 704; u.pm = 16 + (w & 7); u.pn = w >> 3; }
        return true;
    }
    __device__ __forceinline__ void a_ready(const Unit&) const {}
    __device__ __forceinline__ void done(const Unit&) const {}
};
struct FfnTail2Order {
    int c;
    __device__ bool next(int i, Unit& u) const { if (i > 0 || c >= 64) return false; u.pm = 32 + (c >> 2); u.pn = 40 + (c & 3); return true; }
    __device__ __forceinline__ void a_ready(const Unit&) const {}
    __device__ __forceinline__ void done(const Unit&) const {}
};
struct FfnTailOrder {
    int c;
    __device__ bool next(int i, Unit& u) const { if (i > 0 || c >= 128) return false; u.pm = 64 + (c >> 2); u.pn = 40 + (c & 3); return true; }
    __device__ __forceinline__ void a_ready(const Unit&) const {}
    __device__ __forceinline__ void done(const Unit&) const {}
};

struct Ffn3MainOrder {
    int G, c;
    __device__ bool next(int i, Unit& u) const {
        const int L = i * G + c; if (L >= 1280) return false;
        const int w0 = (L % NXCD) * 160 + L / NXCD;
        const int gid = w0 / 320, w = w0 % 320; u.pm = 8 * gid + (w & 7); u.pn = w >> 3; return true;
    }
    __device__ __forceinline__ void a_ready(const Unit&) const {}
    __device__ __forceinline__ void done(const Unit&) const {}
};
struct Ffn3TailOrder {
    int c;
    __device__ bool next(int i, Unit& u) const { if (i > 0 || c >= 192) return false; u.pm = c >> 2; u.pn = 40 + (c & 3); return true; }
    __device__ __forceinline__ void a_ready(const Unit&) const {}
    __device__ __forceinline__ void done(const Unit&) const {}
};


struct EpiSwiGLU {
    static constexpr bool PERM = true, AFTER_DRAIN = false;
    bf16_t* O;
    template <int MB>
    __device__ __forceinline__ void operator()(const f32x4 (&acc)[2][2][MB][2], const Unit& u, int wr, int wc, int fr, int fq) const {
        const int row0 = u.pm * 64 * MB + wr * 16 * MB + fr, col0 = u.pn * HALF + wc * 32 + 8 * fq;
#pragma unroll
        for (int ai = 0; ai < 2; ++ai)
#pragma unroll
            for (int m = 0; m < MB; ++m) {
                bf16_t* rowp = O + (size_t)(row0 + ai * 32 * MB + m * 16) * DFF + col0;
                const f32x4 g0 = acc[ai][0][m][0], g1 = acc[ai][0][m][1], u0 = acc[ai][1][m][0], u1 = acc[ai][1][m][1];
                f32x4 v0, v1;
#pragma unroll
                for (int j = 0; j < 4; ++j) { v0[j] = silu_f(g0[j]) * u0[j]; v1[j] = silu_f(g1[j]) * u1[j]; }
                u32x4 w; w.x = cvt_pk_bf16(v0[0], v0[1]); w.y = cvt_pk_bf16(v0[2], v0[3]); w.z = cvt_pk_bf16(v1[0], v1[1]); w.w = cvt_pk_bf16(v1[2], v1[3]);
                *(u32x4*)rowp = w;
            }
    }
};
__device__ __forceinline__ f32x4 bf4_f4(u32x2 r) { f32x4 o; o[0] = __uint_as_float(r.x << 16); o[1] = __uint_as_float(r.x & 0xffff0000u); o[2] = __uint_as_float(r.y << 16); o[3] = __uint_as_float(r.y & 0xffff0000u); return o; }
__device__ __forceinline__ int row_ms(int row) { return row < MCTX ? 0 : 1 + ((row - MCTX) >> 10); }
template <bool XF32>
struct EpiResT {
    static constexpr bool PERM = false, AFTER_DRAIN = false;
    const void* xa; const void* xb; bf16_t* xo; const float* gate; float coef;
    template <int MB>
    __device__ __forceinline__ void operator()(const f32x4 (&acc)[2][2][MB][2], const Unit& u, int wr, int wc, int fr, int fq) const {
        const int row0 = u.pm * 64 * MB + wr * 16 * MB + fr, col0 = u.pn * BM + wc * 32 + 4 * fq;
        const int ms0 = row_ms(u.pm * 64 * MB); const bool uni = ms0 == row_ms(u.pm * 64 * MB + 64 * MB - 1);
        f32x4 g0[2][2];
#pragma unroll
        for (int bj = 0; bj < 2; ++bj)
#pragma unroll
            for (int n = 0; n < 2; ++n) g0[bj][n] = *(const f32x4*)(gate + ms0 * NMOD + col0 + bj * HALF + n * 16) * coef;
        f32x4 xf[XF32 ? 2 : 1][XF32 ? MB : 1][2][2]; u32x2 xh[XF32 ? 1 : 2][XF32 ? 1 : MB][2][2];
#pragma unroll
        for (int ai = 0; ai < 2; ++ai)
#pragma unroll
            for (int m = 0; m < MB; ++m) {
                const int row = row0 + ai * 32 * MB + m * 16; const void* xin = (row < MCTX) ? xa : xb;
                const size_t off = (size_t)row * D + col0;
#pragma unroll
                for (int bj = 0; bj < 2; ++bj)
#pragma unroll
                    for (int n = 0; n < 2; ++n) {
                        if constexpr (XF32) xf[ai][m][bj][n] = *(const f32x4*)((const float*)xin + off + bj * HALF + n * 16);
                        else xh[ai][m][bj][n] = *(const u32x2*)((const bf16_t*)xin + off + bj * HALF + n * 16); }
            }
#pragma unroll
        for (int ai = 0; ai < 2; ++ai)
#pragma unroll
            for (int m = 0; m < MB; ++m) {
                const int row = row0 + ai * 32 * MB + m * 16;
                const float* gv = gate + row_ms(row) * NMOD;
                const size_t off = (size_t)row * D + col0;
#pragma unroll
                for (int bj = 0; bj < 2; ++bj)
#pragma unroll
                    for (int n = 0; n < 2; ++n) { f32x4 gt = g0[bj][n]; if (!uni) gt = *(const f32x4*)(gv + col0 + bj * HALF + n * 16) * coef;
                        f32x4 xi; if constexpr (XF32) xi = xf[ai][m][bj][n]; else xi = bf4_f4(xh[ai][m][bj][n]);
                        const f32x4 o = xi + gt * acc[ai][bj][m][n];
                        u32x2 w; w.x = cvt_pk_bf16(o[0], o[1]); w.y = cvt_pk_bf16(o[2], o[3]);
                        *(u32x2*)(xo + off + bj * HALF + n * 16) = w; }
            }
    }
};
struct EpiGLU {
    static constexpr bool PERM = false, AFTER_DRAIN = false;
    const bf16_t* xin; bf16_t* xo; const float* gate;
    template <int MB>
    __device__ __forceinline__ void operator()(const f32x4 (&acc)[2][2][MB][2], const Unit& u, int wr, int wc, int fr, int fq) const {
        const int row0 = u.pm * 64 * MB + wr * 16 * MB + fr, col0 = u.pn * HALF + wc * 32 + 4 * fq;
        const int ms0 = row_ms(u.pm * 64 * MB); const bool uni = ms0 == row_ms(u.pm * 64 * MB + 64 * MB - 1);
        f32x4 g0[2];
#pragma unroll
        for (int n = 0; n < 2; ++n) g0[n] = *(const f32x4*)(gate + ms0 * NMOD + col0 + n * 16);
        u32x2 xi[2][MB][2];
#pragma unroll
        for (int ai = 0; ai < 2; ++ai)
#pragma unroll
            for (int m = 0; m < MB; ++m)
#pragma unroll
                for (int n = 0; n < 2; ++n) xi[ai][m][n] = *(const u32x2*)(xin + (size_t)(row0 + ai * 32 * MB + m * 16) * D + col0 + n * 16);
#pragma unroll
        for (int ai = 0; ai < 2; ++ai)
#pragma unroll
            for (int m = 0; m < MB; ++m) {
                const int row = row0 + ai * 32 * MB + m * 16;
                const float* gv = gate + row_ms(row) * NMOD;
                const size_t off = (size_t)row * D + col0;
#pragma unroll
                for (int n = 0; n < 2; ++n) {
                    f32x4 gt = g0[n]; if (!uni) gt = *(const f32x4*)(gv + col0 + n * 16);
                    const f32x4 a = acc[ai][0][m][n], b = acc[ai][1][m][n], x4 = bf4_f4(xi[ai][m][n]); f32x4 o;
#pragma unroll
                    for (int j = 0; j < 4; ++j) o[j] = x4[j] + gt[j] * a[j] * sigmoid_f(b[j]);
                    u32x2 w; w.x = cvt_pk_bf16(o[0], o[1]); w.y = cvt_pk_bf16(o[2], o[3]);
                    *(u32x2*)(xo + off + n * 16) = w;
                }
            }
    }
};
struct EpiF32 {
    static constexpr bool PERM = false, AFTER_DRAIN = false;
    bf16_t* C; int ldc;
    template <int MB>
    __device__ __forceinline__ void operator()(const f32x4 (&acc)[2][2][MB][2], const Unit& u, int wr, int wc, int fr, int fq) const {
        const int row0 = u.pm * 64 * MB + wr * 16 * MB + fr, col0 = u.pn * BM + wc * 32 + 4 * fq;
#pragma unroll
        for (int ai = 0; ai < 2; ++ai)
#pragma unroll
            for (int m = 0; m < MB; ++m) { bf16_t* rowp = C + (size_t)(row0 + ai * 32 * MB + m * 16) * ldc + col0;
#pragma unroll
                for (int bj = 0; bj < 2; ++bj)
#pragma unroll
                    for (int n = 0; n < 2; ++n) { const f32x4 v = acc[ai][bj][m][n]; u32x2 w; w.x = cvt_pk_bf16(v[0], v[1]); w.y = cvt_pk_bf16(v[2], v[3]); *(u32x2*)(rowp + bj * HALF + n * 16) = w; } }
    }
};
struct EpiBf16 {
    static constexpr bool PERM = true, AFTER_DRAIN = false;
    bf16_t* O; int ldc;
    template <int MB>
    __device__ __forceinline__ void operator()(const f32x4 (&acc)[2][2][4][2], const Unit& u, int wr, int wc, int fr, int fq) const {
        const int row0 = u.pm * BM + wr * 64 + fr, col0 = u.pn * BM + wc * 32 + 8 * fq;
#pragma unroll
        for (int ai = 0; ai < 2; ++ai)
#pragma unroll
            for (int m = 0; m < 4; ++m) { bf16_t* rowp = O + (size_t)(row0 + ai * HALF + m * 16) * ldc + col0;
#pragma unroll
                for (int bj = 0; bj < 2; ++bj) { const f32x4 v0 = acc[ai][bj][m][0], v1 = acc[ai][bj][m][1];
                    u32x4 w; w.x = cvt_pk_bf16(v0[0], v0[1]); w.y = cvt_pk_bf16(v0[2], v0[3]); w.z = cvt_pk_bf16(v1[0], v1[1]); w.w = cvt_pk_bf16(v1[2], v1[3]);
                    *(u32x4*)(rowp + bj * HALF) = w; } }
    }
};
struct EpiQ {
    static constexpr bool PERM = false, AFTER_DRAIN = false;
    bf16_t* Q; const float* rc; const float* rs;
    template <int MB>
    __device__ __forceinline__ void operator()(const f32x4 (&acc)[2][2][4][2], const Unit& u, int wr, int wc, int fr, int fq) const {
        const int row0 = u.pm * BM + wr * 64 + fr; const bool lat = u.pm >= 16;
#pragma unroll
        for (int bj = 0; bj < 2; ++bj) {
            const int gi = u.pn * 8 + bj * 4 + wc, sub = gi % 6; const bool pe = lat && (sub >= 4);
            const int colb = gi * 32 + 4 * fq;
#pragma unroll
            for (int ai = 0; ai < 2; ++ai)
#pragma unroll
                for (int m = 0; m < 4; ++m) {
                    const int row = row0 + ai * HALF + m * 16;
                    f32x4 x0 = acc[ai][bj][m][0] * QSCALE, x1 = acc[ai][bj][m][1] * QSCALE;
                    if (pe) {
                        const int t = (row - MCTX) & 1023; const int fo = t * 32 + (sub - 4) * 16 + 4 * fq;
                        const f32x4 c = *(const f32x4*)(rc + fo), s = *(const f32x4*)(rs + fo);
                        const f32x4 y0 = x0 * c - x1 * s, y1 = x1 * c + x0 * s; x0 = y0; x1 = y1;
                    }
                    bf16_t* p = Q + (size_t)row * NQ + colb;
                    u32x2 w0, w1; w0.x = cvt_pk_bf16(x0[0], x0[1]); w0.y = cvt_pk_bf16(x0[2], x0[3]); w1.x = cvt_pk_bf16(x1[0], x1[1]); w1.y = cvt_pk_bf16(x1[2], x1[3]);
                    *(u32x2*)p = w0; *(u32x2*)(p + 16) = w1;
                }
        }
    }
};

template <class Epi, class Sched, bool ALIGN_EPI = false, bool SP2 = false, int MB = 4>
__device__ __forceinline__ void gemm_phase(LAS unsigned char* lds, const Gemm g, const Sched& S, const Epi& E) {
    const int tid = threadIdx.x, wid = __builtin_amdgcn_readfirstlane(tid >> 6), lane = tid & 63, wr = wid >> 2, wc = wid & 3, fr = lane & 15, fq = lane >> 4;
    const int K = g.K, nt = K / BK;
    unsigned voffA[2], voffB[2];
#pragma unroll
    for (int i = 0; i < 2; ++i) { int R, C; stage_rc(tid * 16 + i * 8192, R, C); const int Rb = Epi::PERM ? ((R & ~31) + perm32(R & 31)) : R;
        voffA[i] = (unsigned)(R * K + C) * 2u; voffB[i] = (unsigned)(Rb * K + C) * 2u; }
    const size_t kstep = (size_t)(BK * 2);
    const size_t hstep = (size_t)HALF * K * 2;
    const size_t tstep = 2 * hstep;
    const size_t hstepA = (size_t)(32 * MB) * K * 2;
    const size_t tstepA = 2 * hstepA;
    const unsigned ldsw = (unsigned)wid * 1024u;
    const int aoff = lds_byte(wr * 16 * MB + fr, fq * 8), boff = lds_byte(wc * 32 + fr, fq * 8);
    const bool a2nd = (MB == 4) || (MB == 3 && wr == 0);
#define PG8_SA(b, h) (((b) * 2 + (h)) * HTB)
#define PG8_SB(b, h) ((4 + (b) * 2 + (h)) * HTB)
#define PG8_STAGE(bufoff, gbase, voff) do { _Pragma("unroll") for (int _i = 0; _i < 2; ++_i) \
        __builtin_amdgcn_global_load_lds((const unsigned*)((const char*)(gbase) + (voff)[_i]), (LAS unsigned*)(lds + (bufoff) + ldsw + _i * 8192), 16, 0, 0); } while (0)
#define PG8_STAGEA(bufoff, gbase, voff) do { \
        __builtin_amdgcn_global_load_lds((const unsigned*)((const char*)(gbase) + (voff)[0]), (LAS unsigned*)(lds + (bufoff) + ldsw), 16, 0, 0); \
        if (a2nd) __builtin_amdgcn_global_load_lds((const unsigned*)((const char*)(gbase) + (voff)[1]), (LAS unsigned*)(lds + (bufoff) + ldsw + 8192), 16, 0, 0); } while (0)
#define PG8_WAIT_VA(n4, n3) do { if (!a2nd) asm volatile("s_waitcnt vmcnt(" #n3 ")" ::: "memory"); else asm volatile("s_waitcnt vmcnt(" #n4 ")" ::: "memory"); } while (0)
#define PG8_LDA(dst, b, h) do { _Pragma("unroll") for (int m = 0; m < MB; ++m) _Pragma("unroll") for (int k = 0; k < 2; ++k) dst[m][k] = *(const LAS bf16x8*)(lds + PG8_SA(b, h) + aoff + m * 2048 + k * 1024); } while (0)
#define PG8_LDB(dst, b, h) do { _Pragma("unroll") for (int n = 0; n < 2; ++n) _Pragma("unroll") for (int k = 0; k < 2; ++k) dst[n][k] = *(const LAS bf16x8*)(lds + PG8_SB(b, h) + boff + n * 2048 + k * 1024); } while (0)
#define PG8_MMA(ai, bj, At, Bt) do { __builtin_amdgcn_s_setprio(1); _Pragma("unroll") for (int m = 0; m < MB; ++m) _Pragma("unroll") for (int n = 0; n < 2; ++n) _Pragma("unroll") for (int k = 0; k < 2; ++k) \
        acc[ai][bj][m][n] = __builtin_amdgcn_mfma_f32_16x16x32_bf16(Bt[n][k], At[m][k], acc[ai][bj][m][n], 0, 0, 0); __builtin_amdgcn_s_setprio(0); } while (0)
#define PG8_WAIT_V(n) asm volatile("s_waitcnt vmcnt(" #n ")" ::: "memory")
#define PG8_WAIT_L(n) asm volatile("s_waitcnt lgkmcnt(" #n ")" ::: "memory")
#define PG8_BAR __builtin_amdgcn_s_barrier()
#define PG8_SCHED __builtin_amdgcn_sched_barrier(0)
    Unit cur, nxt; int ui = 0;
    if (!S.next(0, cur)) return;
    f32x4 acc[2][2][MB][2];
#pragma unroll
    for (int a = 0; a < 2; ++a)
#pragma unroll
        for (int b = 0; b < 2; ++b)
#pragma unroll
            for (int m = 0; m < MB; ++m)
#pragma unroll
                for (int n = 0; n < 2; ++n) acc[a][b][m][n] = (f32x4){0.f, 0.f, 0.f, 0.f};
    bf16x8 At[MB][2], B0[2][2], B1[2][2];
    const char* cA = (const char*)g.A + (size_t)cur.pm * tstepA; const char* cB = (const char*)g.Bt + (size_t)cur.pn * tstep;
    S.a_ready(cur);
    if constexpr (SP2) {
        PG8_STAGE(PG8_SB(0, 0), cB, voffB); PG8_STAGE(PG8_SB(0, 1), cB + hstep, voffB); PG8_STAGEA(PG8_SA(0, 0), cA, voffA); PG8_STAGEA(PG8_SA(0, 1), cA + hstepA, voffA);
        if (wr == 1) PG8_BAR;
        PG8_WAIT_VA(2, 1); PG8_BAR;
        PG8_STAGE(PG8_SB(1, 0), cB + kstep, voffB); PG8_STAGEA(PG8_SA(1, 0), cA + kstep, voffA); PG8_STAGE(PG8_SB(1, 1), cB + hstep + kstep, voffB);
        PG8_WAIT_VA(6, 5); PG8_BAR;
    } else {
        PG8_STAGE(PG8_SB(0, 0), cB, voffB); PG8_STAGEA(PG8_SA(0, 0), cA, voffA); PG8_STAGE(PG8_SB(0, 1), cB + hstep, voffB); PG8_STAGEA(PG8_SA(0, 1), cA + hstepA, voffA);
        if (wr == 1) PG8_BAR;
        PG8_WAIT_V(4); PG8_BAR;
        PG8_STAGE(PG8_SB(1, 0), cB + kstep, voffB); PG8_STAGEA(PG8_SA(1, 0), cA + kstep, voffA); PG8_STAGE(PG8_SB(1, 1), cB + hstep + kstep, voffB);
        PG8_WAIT_V(6); PG8_BAR;
    }
    for (;;) {
        const bool has_next = S.next(ui + 1, nxt);
        const char* nA = has_next ? (const char*)g.A + (size_t)nxt.pm * tstepA : cA; const char* nB = has_next ? (const char*)g.Bt + (size_t)nxt.pn * tstep : cB;
        for (int t = 0; t < nt; t += 2) {
            const bool last = (t == nt - 2);
            const char* a1 = cA + (size_t)(t + 1) * kstep;
            const char* a2 = last ? nA : cA + (size_t)(t + 2) * kstep; const char* b2 = last ? nB : cB + (size_t)(t + 2) * kstep;
            const char* a3 = a2 + kstep; const char* b3 = b2 + kstep;
            if (last && has_next) S.a_ready(nxt);
            if constexpr (SP2) {
            PG8_LDB(B0, 0, 0); PG8_LDB(B1, 0, 1); PG8_SCHED; PG8_LDA(At, 0, 0); PG8_STAGEA(PG8_SA(1, 1), a1 + hstepA, voffA);
            PG8_WAIT_VA(8, 6); PG8_WAIT_L(0); PG8_BAR; PG8_MMA(0, 0, At, B0); PG8_MMA(0, 1, At, B1); PG8_BAR; PG8_SCHED;
            PG8_LDA(At, 0, 1); PG8_STAGE(PG8_SB(0, 0), b2, voffB); PG8_STAGE(PG8_SB(0, 1), b2 + hstep, voffB); PG8_STAGEA(PG8_SA(0, 0), a2, voffA);
            PG8_WAIT_VA(8, 6); PG8_WAIT_L(0); PG8_BAR; PG8_MMA(1, 0, At, B0); PG8_MMA(1, 1, At, B1); PG8_BAR; PG8_SCHED;
            PG8_LDB(B0, 1, 0); PG8_LDB(B1, 1, 1); PG8_SCHED; PG8_LDA(At, 1, 0); PG8_STAGEA(PG8_SA(0, 1), a2 + hstepA, voffA);
            PG8_WAIT_VA(8, 6); PG8_WAIT_L(0); PG8_BAR; PG8_MMA(0, 0, At, B0); PG8_MMA(0, 1, At, B1); PG8_BAR; PG8_SCHED;
            PG8_LDA(At, 1, 1); PG8_STAGE(PG8_SB(1, 0), b3, voffB); PG8_STAGE(PG8_SB(1, 1), b3 + hstep, voffB); PG8_STAGEA(PG8_SA(1, 0), a3, voffA);
            PG8_WAIT_VA(8, 6); PG8_WAIT_L(0); PG8_BAR; PG8_MMA(1, 0, At, B0); PG8_MMA(1, 1, At, B1); PG8_BAR; PG8_SCHED;
            } else {
            PG8_LDB(B0, 0, 0); PG8_SCHED; PG8_LDA(At, 0, 0); PG8_STAGEA(PG8_SA(1, 1), a1 + hstepA, voffA);
            PG8_WAIT_L(8); PG8_BAR; PG8_WAIT_L(0); PG8_MMA(0, 0, At, B0); PG8_BAR; PG8_SCHED;
            PG8_LDB(B1, 0, 1); PG8_STAGE(PG8_SB(0, 0), b2, voffB);
            PG8_BAR; PG8_WAIT_L(0); PG8_MMA(0, 1, At, B1); PG8_BAR;
            PG8_LDA(At, 0, 1); PG8_STAGEA(PG8_SA(0, 0), a2, voffA);
            PG8_BAR; PG8_WAIT_L(0); PG8_MMA(1, 0, At, B0); PG8_BAR; PG8_SCHED;
            PG8_STAGE(PG8_SB(0, 1), b2 + hstep, voffB);
            PG8_WAIT_V(6); PG8_BAR; PG8_MMA(1, 1, At, B1); PG8_BAR;
            PG8_LDB(B0, 1, 0); PG8_SCHED; PG8_LDA(At, 1, 0); PG8_STAGEA(PG8_SA(0, 1), a2 + hstepA, voffA);
            PG8_WAIT_L(8); PG8_BAR; PG8_WAIT_L(0); PG8_MMA(0, 0, At, B0); PG8_BAR; PG8_SCHED;
            PG8_LDB(B1, 1, 1); PG8_STAGE(PG8_SB(1, 0), b3, voffB);
            PG8_BAR; PG8_WAIT_L(0); PG8_MMA(0, 1, At, B1); PG8_BAR;
            PG8_LDA(At, 1, 1); PG8_STAGEA(PG8_SA(1, 0), a3, voffA);
            PG8_BAR; PG8_WAIT_L(0); PG8_MMA(1, 0, At, B0); PG8_BAR; PG8_SCHED;
            PG8_STAGE(PG8_SB(1, 1), b3 + hstep, voffB);
            PG8_WAIT_V(6); PG8_BAR; PG8_MMA(1, 1, At, B1); PG8_BAR;
            }
        }
        if constexpr (ALIGN_EPI) { if (wr == 0) PG8_BAR; }
        if constexpr (!Epi::AFTER_DRAIN) { E.template operator()<MB>(acc, cur, wr, wc, fr, fq); S.done(cur); }
        if (!has_next) break;
#pragma unroll
        for (int a = 0; a < 2; ++a)
#pragma unroll
            for (int b = 0; b < 2; ++b)
#pragma unroll
                for (int m = 0; m < MB; ++m)
#pragma unroll
                    for (int n = 0; n < 2; ++n) acc[a][b][m][n] = (f32x4){0.f, 0.f, 0.f, 0.f};
        cur = nxt; cA = nA; cB = nB; ++ui;
        if constexpr (ALIGN_EPI) { if (wr == 1) PG8_BAR; }
    }
    PG8_WAIT_V(0);
    if constexpr (!ALIGN_EPI) { if (wr == 0) PG8_BAR; }
    PG8_BAR;
#undef PG8_SA
#undef PG8_SB
#undef PG8_STAGE
#undef PG8_STAGEA
#undef PG8_WAIT_VA
#undef PG8_LDA
#undef PG8_LDB
#undef PG8_MMA
#undef PG8_WAIT_V
#undef PG8_WAIT_L
#undef PG8_BAR
#undef PG8_SCHED
}
}

#define XB_TMO      128
#define XB_XCNT(j)  (256  + 64 * (j))
#define XB_XSUB(j)  (1280 + 64 * (j))
#define XB_XGEN(j)  (2304 + 64 * (j))
#define XB_TOP      3328
#define XB_TOPGEN   3392
#define XCD_BAR_WORDS 3456
#define XB_SPIN_CAP (1u << 18)
__device__ __forceinline__ unsigned xb_ld(unsigned* p)              { return __hip_atomic_load(p, __ATOMIC_RELAXED, __HIP_MEMORY_SCOPE_AGENT); }
__device__ __forceinline__ unsigned xb_add(unsigned* p, unsigned v) { return __hip_atomic_fetch_add(p, v, __ATOMIC_RELAXED, __HIP_MEMORY_SCOPE_AGENT); }
__device__ __forceinline__ unsigned xb_xcc_id() { return (unsigned)__builtin_amdgcn_s_getreg((3 << 11) | 20) & 0xFu; }
#define XB_SPIN(cond, bar) do { unsigned _sp = 0; while (cond) { __builtin_amdgcn_s_sleep(1); \
    if ((++_sp & 255u) == 0u) { if (xb_ld(&(bar)[XB_TMO])) break; if (_sp > XB_SPIN_CAP) { atomicAdd(&(bar)[XB_TMO], 1u); break; } } } } while (0)
struct XcdBarrier { unsigned* bar; unsigned x; volatile LAS unsigned* st; };
__device__ __forceinline__ XcdBarrier xcd_barrier_post(unsigned* bar, volatile LAS unsigned* st) {
    XcdBarrier b; b.bar = bar; b.x = xb_xcc_id(); b.st = st;
    if (threadIdx.x == 0) (void)xb_add(&bar[XB_XCNT(b.x)], 1u);
    return b;
}
__device__ __forceinline__ void xcd_barrier_complete(unsigned* bar, unsigned x, unsigned& nloc, unsigned& nx) {
    const unsigned G = gridDim.x * gridDim.y * gridDim.z;
    unsigned sum, cnt, mine, sp = 0u;
    for (;;) {
        sum = 0u; cnt = 0u; mine = 0u;
#pragma unroll
        for (unsigned j = 0; j < 16; ++j) { const unsigned c = xb_ld(&bar[XB_XCNT(j)]); sum += c; cnt += (c > 0u) ? 1u : 0u; mine = (j == x) ? c : mine; }
        if (sum == G) break;
        __builtin_amdgcn_s_sleep(1);
        if ((++sp & 255u) == 0u) { if (xb_ld(&bar[XB_TMO])) break; if (sp > XB_SPIN_CAP) { atomicAdd(&bar[XB_TMO], 1u); break; } }
    }
    nloc = mine > 0u ? mine : 1u; nx = cnt > 0u ? cnt : 1u;
}
__device__ __forceinline__ void xcd_barrier(const XcdBarrier& b) {
    asm volatile("s_waitcnt vmcnt(0)" ::: "memory");
    __syncthreads();
    if (threadIdx.x == 0) {
        unsigned* bar = b.bar;
        __builtin_amdgcn_s_waitcnt(0);
        unsigned nloc = b.st[0], nx = b.st[1];
        if (nloc == 0u) { xcd_barrier_complete(bar, b.x, nloc, nx); b.st[0] = nloc; b.st[1] = nx; }
        const unsigned old = xb_add(&bar[XB_XSUB(b.x)], 1u);
        const unsigned gen = old / nloc;
        if (old + 1u == (gen + 1u) * nloc) {
            __builtin_amdgcn_fence(__ATOMIC_RELEASE, "agent");
            asm volatile("s_waitcnt vmcnt(0)" ::: "memory");
            const unsigned og = xb_add(&bar[XB_TOP], 1u);
            const unsigned tg = og / nx;
            if (og + 1u == (tg + 1u) * nx) xb_add(&bar[XB_TOPGEN], 1u);
            else XB_SPIN(xb_ld(&bar[XB_TOPGEN]) == tg, bar);
            __builtin_amdgcn_fence(__ATOMIC_ACQUIRE, "agent");
            xb_add(&bar[XB_XGEN(b.x)], 1u);
            asm volatile("s_waitcnt vmcnt(0)" ::: "memory");
        } else {
            XB_SPIN(xb_ld(&bar[XB_XGEN(b.x)]) == gen, bar);
            __builtin_amdgcn_fence(__ATOMIC_ACQUIRE, "agent");
            asm volatile("s_waitcnt vmcnt(0)" ::: "memory");
        }
    }
    __syncthreads();
}

struct Args { const float* in[30]; float* out; unsigned char* ws; int ph_lo, ph_hi, use_bar, pad; };
struct Frame {
    LAS unsigned char* lds;
    int tid, lane, wave, vcu, G;
};
typedef const __attribute__((address_space(4))) Args* KA;
__device__ __forceinline__ KA get_ka() { KA p = (KA)__builtin_amdgcn_kernarg_segment_ptr(); asm volatile("" : "+s"(p)); return p; }
#define IN_(i) (ka->in[i])
#define WS_ (ka->ws)
#define OUT_ (ka->out)
#define MODS_ ((float*)(ka->ws + WS_MODS))
#define ROPEC_ ((float*)(ka->ws + WS_ROPE))
#define ROPES_ ((float*)(ka->ws + WS_ROPE) + 1024 * 32)
enum { I_XP = 0, I_XS, I_CCKV, I_CKPE, I_SRE, I_SIM, I_C, I_CCTX, I_MODW, I_MODB, I_NORMG, I_WIN, I_WOUT, I_WDQ, I_QNORM, I_WUQ, I_WDKV, I_KVNORM, I_WUKV, I_WO,
       I_ARE, I_AIM, I_LOGDT, I_BRE, I_BIM, I_CRE, I_CIM, I_S5D, I_WGLU, I_FING };

__device__ __forceinline__ void tr_item(const float* W, int K, int N, bf16_t* WT, int k0, int n0, LAS float* scr, int lane) {
    const int lr = lane >> 4, lc = lane & 15;
    f32x4 v[16];
#pragma unroll
    for (int i = 0; i < 16; ++i) v[i] = __builtin_nontemporal_load((const f32x4*)(W + (size_t)(k0 + 4 * i + lr) * N + n0 + 4 * lc));
#pragma unroll
    for (int i = 0; i < 16; ++i) { const int k = 4 * i + lr; *(LAS f32x4*)(scr + k * 64 + ((4 * lc) ^ (4 * ((k >> 3) & 7)))) = v[i]; }
    asm volatile("s_waitcnt lgkmcnt(0)" ::: "memory");
    const int c = lane & 7;
#pragma unroll
    for (int j = 0; j < 8; ++j) {
        const int n = (lane >> 3) + 8 * j; const LAS float* s = scr + (8 * c) * 64 + (n ^ (4 * c));
        u32x4 o; o.x = cvt_pk_bf16(s[0 * 64], s[1 * 64]); o.y = cvt_pk_bf16(s[2 * 64], s[3 * 64]); o.z = cvt_pk_bf16(s[4 * 64], s[5 * 64]); o.w = cvt_pk_bf16(s[6 * 64], s[7 * 64]);
        *(u32x4*)(WT + (size_t)n * K + k0 + 8 * c) = o;
    }
    asm volatile("s_waitcnt lgkmcnt(0)" ::: "memory");
}
__device__ __forceinline__ int ilv_row(int n, int Hh) { const int hi = n >= Hh ? 1 : 0; const int c = n - hi * Hh; return 256 * (c >> 7) + 128 * hi + (c & 127); }

__device__ __forceinline__ int conv_items(int m) {
    return m < 4 ? 32 * 176 : m < 8 ? 88 * 32 : m == 8 ? 32 * 12 : m == 9 ? 32 * 9 : m == 10 ? 12 * 48 : m == 11 ? 8 * 64 : m == 12 ? 32 * 32 : 32 * 64;
}
__device__ __forceinline__ void conv_item(KA ka, int m, int r, LAS float* scr, int lane) {
    if (m < 4) { const int kb = r / 176, nb = r % 176;
        tr_item(IN_(I_WIN) + (size_t)m * D * NFF2, D, NFF2, (bf16_t*)(WS_ + WS_WIN) + (size_t)m * NFF2 * D + (size_t)ilv_row(64 * nb, DFF) * D, 64 * kb, 64 * nb, scr, lane); }
    else if (m < 8) { const int mi = m - 4, kb = r / 32, nb = r % 32;
        tr_item(IN_(I_WOUT) + (size_t)mi * DFF * D, DFF, D, (bf16_t*)(WS_ + WS_WOUT) + (size_t)mi * D * DFF + (size_t)(64 * nb) * DFF, 64 * kb, 64 * nb, scr, lane); }
    else if (m == 8) { const int kb = r / 12, nb = r % 12;
        tr_item(IN_(I_WDQ), D, QL, (bf16_t*)(WS_ + WS_WA) + (size_t)(64 * nb) * D, 64 * kb, 64 * nb, scr, lane); }
    else if (m == 9) { const int kb = r / 9, nb = r % 9;
        tr_item(IN_(I_WDKV), D, 576, (bf16_t*)(WS_ + WS_WA) + (size_t)(QL + 64 * nb) * D, 64 * kb, 64 * nb, scr, lane); }
    else if (m == 10) { const int kb = r / 48, nb = r % 48;
        tr_item(IN_(I_WUQ), QL, NQ, (bf16_t*)(WS_ + WS_WUQ) + (size_t)(64 * nb) * QL, 64 * kb, 64 * nb, scr, lane); }
    else if (m == 11) { const int kb = r / 64, nb = r % 64; const int n0 = 64 * nb, hh = n0 >> 8, j = n0 & 255; const int drow = (j < 128 ? 0 : 2048) + hh * 128 + (j & 127);
        tr_item(IN_(I_WUKV), KVL, 4096, (bf16_t*)(WS_ + WS_WUK) + (size_t)drow * KVL, 64 * kb, n0, scr, lane); }
    else if (m == 12) { const int kb = r / 32, nb = r % 32;
        tr_item(IN_(I_WO), D, D, (bf16_t*)(WS_ + WS_WO) + (size_t)(64 * nb) * D, 64 * kb, 64 * nb, scr, lane); }
    else { const int kb = r / 64, nb = r % 64;
        tr_item(IN_(I_WGLU), D, 4096, (bf16_t*)(WS_ + WS_WGLU) + (size_t)ilv_row(64 * nb, D) * D, 64 * kb, 64 * nb, scr, lane); }
}
constexpr int WIN1_SPLIT = 1792;
__device__ __forceinline__ unsigned conv_slot_mask(int slot) {
    return slot == 0 ? (1u << 0)
         : slot == 1 ? ((1u << 4) | (1u << 8) | (1u << 9) | (1u << 10) | (1u << 11) | (1u << 12) | (1u << 1))
         : slot == 2 ? (1u << 1)
         : slot == 3 ? ((1u << 5) | (1u << 2))
         : slot == 6 ? (1u << 13)
         : slot == 4 ? ((1u << 6) | (1u << 3))
         : (1u << 7);
}
__device__ __forceinline__ void convert_slot(Frame& F, KA ka, int slot, int worker, int nworkers) {
    LAS float* scr = (LAS float*)(F.lds + F.wave * 16384);
    const unsigned mask = conv_slot_mask(slot);
    int base = 0;
#pragma unroll 1
    for (int m = 0; m < 14; ++m) {
        if (!((mask >> m) & 1u)) continue;
        int lo = 0, hi = conv_items(m);
        if (m == 1) { if (slot == 1) hi = WIN1_SPLIT; else lo = WIN1_SPLIT; }
        const int n = hi - lo;
        int it = worker - (base % nworkers); if (it < 0) it += nworkers;
        for (; it < n; it += nworkers) conv_item(ka, m, lo + it, scr, F.lane);
        base += n;
    }
}
__device__ __forceinline__ void phase_prologue(Frame& F) {
    KA ka = get_ka();
    const int tid = F.tid;
    for (int i = blockIdx.x * 512 + tid; i < 1024 * 32; i += F.G * 512) {
        const int t = i >> 5, f = i & 31; const int pos = (f < 16) ? (t >> 6) : (t & 63);
        const float inv = exp2f(-(float)(f & 15) * (13.287712379549449f / 16.0f));
        const float ang = (float)pos * inv;
        ROPEC_[i] = cosf(ang); ROPES_[i] = sinf(ang);
    }
    {
        bf16_t* ckv = (bf16_t*)(WS_ + WS_CKV); bf16_t* kpe = (bf16_t*)(WS_ + WS_KPE);
        for (int i = blockIdx.x * 512 + tid; i < 2 * 256 * 128; i += F.G * 512) {
            const int row = i >> 7, c4 = i & 127, b = row >> 8, s = row & 255;
            const f32x4 v = *(const f32x4*)(IN_(I_CCKV) + (size_t)row * 512 + 4 * c4);
            u32x2 w; w.x = cvt_pk_bf16(v[0], v[1]); w.y = cvt_pk_bf16(v[2], v[3]);
            *(u32x2*)(ckv + (size_t)(MCTX + b * 1280 + s) * 512 + 4 * c4) = w;
        }
        for (int i = blockIdx.x * 512 + tid; i < 2 * 256 * 16; i += F.G * 512) {
            const int row = i >> 4, c4 = i & 15, b = row >> 8, s = row & 255;
            const f32x4 v = *(const f32x4*)(IN_(I_CKPE) + (size_t)row * 64 + 4 * c4);
            u32x2 w; w.x = cvt_pk_bf16(v[0], v[1]); w.y = cvt_pk_bf16(v[2], v[3]);
            *(u32x2*)(kpe + (size_t)(MCTX + b * 1280 + s) * 64 + 4 * c4) = w;
        }
    }
    {
        LAS float* sc = (LAS float*)F.lds;
        LAS float* red = sc + 3 * 2048;
        for (int i = tid; i < 3 * 2048; i += 512) { const int s = i >> 11, k = i & 2047; const float v = (s == 0) ? IN_(I_CCTX)[k] : IN_(I_C)[(s - 1) * 2048 + k]; sc[i] = v / (1.0f + expf(-v)); }
        __syncthreads();
        const int c4 = tid & 31, kg = tid >> 5;
        for (int tile = blockIdx.x; tile < 288; tile += F.G) {
            const int l = tile / 144, n0 = (tile % 144) * 128;
            const float* wp = IN_(I_MODW) + ((size_t)l * 2048 + kg * 128) * NMOD + n0 + 4 * c4;
            f32x4 a0 = {0.f, 0.f, 0.f, 0.f}, a1 = a0, a2 = a0;
#pragma unroll 8
            for (int j = 0; j < 128; ++j) {
                const f32x4 w = __builtin_nontemporal_load((const f32x4*)(wp + (size_t)j * NMOD));
                const int k = kg * 128 + j; a0 += w * sc[k]; a1 += w * sc[2048 + k]; a2 += w * sc[4096 + k];
            }
#pragma unroll
            for (int i = 0; i < 4; ++i) { red[(kg * 3 + 0) * 128 + 4 * c4 + i] = a0[i]; red[(kg * 3 + 1) * 128 + 4 * c4 + i] = a1[i]; red[(kg * 3 + 2) * 128 + 4 * c4 + i] = a2[i]; }
            __syncthreads();
            if (tid < 384) {
                const int s = tid >> 7, n = tid & 127; float sum = 0.f;
#pragma unroll 8
                for (int g = 0; g < 16; ++g) sum += red[(g * 3 + s) * 128 + n];
                MODS_[(size_t)(l * 3 + s) * NMOD + n0 + n] = sum + IN_(I_MODB)[l * NMOD + n0 + n];
            }
            __syncthreads();
        }
    }
    __syncthreads();
    {
        LAS float* scr = (LAS float*)(F.lds + F.wave * 16384);
        if ((int)blockIdx.x >= 32) { const int nb2 = F.G - 32; for (int it = ((int)blockIdx.x - 32) * 8 + F.wave; it < 5632; it += nb2 * 8) conv_item(ka, 0, it, scr, F.lane); }
    }
}

__device__ __forceinline__ void phase_norm(Frame& F, int l, int sub, bool first_sub) {
    KA ka = get_ka();
    const float* xa = IN_(I_XP); const float* xb = IN_(I_XS) - (size_t)MCTX * D; const bf16_t* X = (const bf16_t*)(WS_ + WS_X);
    const int gw = F.vcu * 8 + F.wave, NGW = F.G * 8, lane = F.lane;
    bf16_t* H = (bf16_t*)(WS_ + WS_H);
    const float* gp = IN_(I_NORMG) + (size_t)(l * 3 + sub) * D;
    for (int chunk = gw; chunk < MT / 3; chunk += NGW) {
        f32x4 vf[3][8]; u32x2 vh[3][8];
#pragma unroll
        for (int r = 0; r < 3; ++r) {
            const int row = 3 * chunk + r; const float* xr = (row < MCTX ? xa : xb) + (size_t)row * D;
#pragma unroll
            for (int j = 0; j < 8; ++j) { if (first_sub) vf[r][j] = *(const f32x4*)(xr + 4 * lane + 256 * j); else vh[r][j] = *(const u32x2*)(X + (size_t)row * D + 4 * lane + 256 * j); }
        }
        int ms_have = -1; f32x4 gs[8], sh[8];
#pragma unroll
        for (int r = 0; r < 3; ++r) {
            const int row = 3 * chunk + r;
            const int ms = row < MCTX ? 0 : 1 + ((row - MCTX) >> 10);
            if (ms != ms_have) {
                const float* mv = MODS_ + (size_t)(l * 3 + ms) * NMOD + sub * 3 * D;
#pragma unroll
                for (int j = 0; j < 8; ++j) { const int idx = 4 * lane + 256 * j; gs[j] = *(const f32x4*)(gp + idx) * (*(const f32x4*)(mv + D + idx) + 1.0f); sh[j] = *(const f32x4*)(mv + idx); }
                ms_have = ms;
            }
            f32x4 v[8]; float ss = 0.f;
#pragma unroll
            for (int j = 0; j < 8; ++j) { v[j] = first_sub ? vf[r][j] : pg8::bf4_f4(vh[r][j]); ss += (v[j][0] * v[j][0] + v[j][1] * v[j][1]) + (v[j][2] * v[j][2] + v[j][3] * v[j][3]); }
            ss = wave_sum(ss);
            const float rstd = 1.0f / sqrtf(ss * (1.0f / D) + EPS);
#pragma unroll
            for (int j = 0; j < 8; ++j) {
                const f32x4 o = v[j] * rstd * gs[j] + sh[j];
                u32x2 w; w.x = cvt_pk_bf16(o[0], o[1]); w.y = cvt_pk_bf16(o[2], o[3]);
                *(u32x2*)(H + (size_t)row * D + 4 * lane + 256 * j) = w;
            }
        }
    }
}
__device__ __forceinline__ void phase_final(Frame& F) {
    KA ka = get_ka();
    const int gw = F.vcu * 8 + F.wave, NGW = F.G * 8, lane = F.lane;
    const bf16_t* X = (const bf16_t*)(WS_ + WS_X); const float* gp = IN_(I_FING);
    f32x4 gq[8];
#pragma unroll
    for (int j = 0; j < 8; ++j) gq[j] = *(const f32x4*)(gp + 4 * lane + 256 * j);
    for (int row0 = gw; row0 < MT; row0 += 3 * NGW) {
        u32x2 vh[3][8];
#pragma unroll
        for (int r = 0; r < 3; ++r) { const int row = row0 + r * NGW; const bf16_t* xr = X + (size_t)(row < MT ? row : row0) * D;
#pragma unroll
            for (int j = 0; j < 8; ++j) vh[r][j] = *(const u32x2*)(xr + 4 * lane + 256 * j); }
#pragma unroll
        for (int r = 0; r < 3; ++r) {
            const int row = row0 + r * NGW; if (row >= MT) break;
            f32x4 v[8]; float ss = 0.f;
#pragma unroll
            for (int j = 0; j < 8; ++j) { v[j] = pg8::bf4_f4(vh[r][j]); ss += (v[j][0] * v[j][0] + v[j][1] * v[j][1]) + (v[j][2] * v[j][2] + v[j][3] * v[j][3]); }
            ss = wave_sum(ss);
            const float rstd = 1.0f / sqrtf(ss * (1.0f / D) + EPS);
#pragma unroll
            for (int j = 0; j < 8; ++j) { const int idx = 4 * lane + 256 * j; __builtin_nontemporal_store(v[j] * rstd * gq[j], (f32x4*)(OUT_ + OUT_Y + (size_t)row * D + idx)); }
        }
    }
}
__device__ __forceinline__ void phase_mla_norm(Frame& F) {
    KA ka = get_ka();
    const int gw = F.vcu * 8 + F.wave, NGW = F.G * 8, lane = F.lane;
    const bf16_t* C = (const bf16_t*)(WS_ + WS_CQKV);
    bf16_t* CQ = (bf16_t*)(WS_ + WS_CQ); bf16_t* CKV = (bf16_t*)(WS_ + WS_CKV); bf16_t* KPE = (bf16_t*)(WS_ + WS_KPE);
    const float* qn = IN_(I_QNORM); const float* kn = IN_(I_KVNORM);
    f32x4 qg[3], kg[2];
#pragma unroll
    for (int j = 0; j < 3; ++j) qg[j] = *(const f32x4*)(qn + 4 * lane + 256 * j);
#pragma unroll
    for (int j = 0; j < 2; ++j) kg[j] = *(const f32x4*)(kn + 4 * lane + 256 * j);
    for (int row = gw; row < MT; row += NGW) {
        const bf16_t* cr = C + (size_t)row * NA;
        const bool lat = row >= MCTX; const int lb = (row - MCTX) >> 10, t = (row - MCTX) & 1023;
        const int drow = lat ? (MCTX + lb * 1280 + 256 + t) : row;
        f32x4 a[3]; float ss = 0.f;
#pragma unroll
        for (int j = 0; j < 3; ++j) { a[j] = pg8::bf4_f4(*(const u32x2*)(cr + 4 * lane + 256 * j)); ss += (a[j][0] * a[j][0] + a[j][1] * a[j][1]) + (a[j][2] * a[j][2] + a[j][3] * a[j][3]); }
        ss = wave_sum(ss);
        float rstd = 1.0f / sqrtf(ss * (1.0f / QL) + EPS);
#pragma unroll
        for (int j = 0; j < 3; ++j) { const int idx = 4 * lane + 256 * j; const f32x4 o = a[j] * rstd * qg[j];
            u32x2 w; w.x = cvt_pk_bf16(o[0], o[1]); w.y = cvt_pk_bf16(o[2], o[3]); *(u32x2*)(CQ + (size_t)row * QL + idx) = w; }
        f32x4 b[2]; ss = 0.f;
#pragma unroll
        for (int j = 0; j < 2; ++j) { b[j] = pg8::bf4_f4(*(const u32x2*)(cr + QL + 4 * lane + 256 * j)); ss += (b[j][0] * b[j][0] + b[j][1] * b[j][1]) + (b[j][2] * b[j][2] + b[j][3] * b[j][3]); }
        ss = wave_sum(ss);
        rstd = 1.0f / sqrtf(ss * (1.0f / KVL) + EPS);
#pragma unroll
        for (int j = 0; j < 2; ++j) { const int idx = 4 * lane + 256 * j; const f32x4 o = b[j] * rstd * kg[j];
            u32x2 w; w.x = cvt_pk_bf16(o[0], o[1]); w.y = cvt_pk_bf16(o[2], o[3]); *(u32x2*)(CKV + (size_t)drow * KVL + idx) = w;
            if (!lat) *(f32x4*)(OUT_ + OUT_CKV + (size_t)row * KVL + idx) = o; }
        float kv = __uint_as_float((unsigned)(*(const unsigned short*)(cr + QL + KVL + lane)) << 16);
        if (!lat) OUT_[OUT_KPE + (size_t)row * 64 + lane] = kv;
        const float partner = __shfl_xor(kv, 16);
        if (lat) {
            const int f = (lane & 15) + 16 * (lane >> 5);
            const float c = ROPEC_[t * 32 + f], s = ROPES_[t * 32 + f];
            const float rot = (lane & 16) ? partner : -partner;
            kv = kv * c + rot * s;
        }
        const float nb = __shfl_down(kv, 1);
        if ((lane & 1) == 0) *(unsigned*)(KPE + (size_t)drow * 64 + lane) = cvt_pk_bf16(kv, nb);
    }
}

constexpr int AT_KROW = 416, AT_VROW = 160, AT_KT = 64 * AT_KROW, AT_VT = 128 * AT_VROW, AT_STAGE = AT_KT + AT_VT;
__device__ __forceinline__ float xg_max(float v) {
    auto a = __builtin_amdgcn_permlane16_swap(__float_as_uint(v), __float_as_uint(v), false, false);
    v = fmaxf(__uint_as_float(a[0]), __uint_as_float(a[1]));
    auto b = __builtin_amdgcn_permlane32_swap(__float_as_uint(v), __float_as_uint(v), false, false);
    return fmaxf(__uint_as_float(b[0]), __uint_as_float(b[1]));
}
__device__ __forceinline__ float xg_sum(float v) {
    auto a = __builtin_amdgcn_permlane16_swap(__float_as_uint(v), __float_as_uint(v), false, false);
    v = __uint_as_float(a[0]) + __uint_as_float(a[1]);
    auto b = __builtin_amdgcn_permlane32_swap(__float_as_uint(v), __float_as_uint(v), false, false);
    return __uint_as_float(b[0]) + __uint_as_float(b[1]);
}
__device__ __forceinline__ void phase_attn(Frame& F) {
    KA ka = get_ka();
    const int tid = F.tid, lane = F.lane, wave = F.wave, l15 = lane & 15, g4 = lane >> 4;
    const bf16_t* Q = (const bf16_t*)(WS_ + WS_Q); const bf16_t* KN = (const bf16_t*)(WS_ + WS_KN); const bf16_t* KPE = (const bf16_t*)(WS_ + WS_KPE);
    const bf16_t* VT = (const bf16_t*)(WS_ + WS_VT); bf16_t* O = (bf16_t*)(WS_ + WS_O);
    LAS unsigned char* lds = F.lds;
    for (int unit = F.vcu; unit < 768; unit += F.G) {
        int b, h, qb, qrow0, krow0, nk;
        if (unit < 256) { b = unit >> 7; h = (unit >> 3) & 15; qb = unit & 7; qrow0 = MCTX + b * 1024 + qb * 128; krow0 = MCTX + b * 1280; nk = 1280; }
        else { const int u2 = unit - 256; b = u2 >> 5; h = (u2 >> 1) & 15; qb = u2 & 1; qrow0 = b * 256 + qb * 128; krow0 = b * 256; nk = 256; }
        const int ntile = nk >> 6;
        bf16x8 qf[6];
        { const bf16_t* qp = Q + (size_t)(qrow0 + wave * 16 + l15) * NQ + h * 192 + 8 * g4;
#pragma unroll
          for (int s = 0; s < 6; ++s) qf[s] = *(const bf16x8*)(qp + 32 * s); }
        const bf16_t* ksrc[3]; int kdst[3]; int kstr[3];
#pragma unroll
        for (int i = 0; i < 3; ++i) { const int idx = tid + 512 * i, row = idx / 24, ch = idx % 24;
            const int key = 32 * (row >> 5) + 8 * ((row >> 2) & 3) + 4 * ((row >> 4) & 1) + (row & 3);
            ksrc[i] = (ch < 16) ? KN + (size_t)(krow0 + key) * D + h * 128 + ch * 8 : KPE + (size_t)(krow0 + key) * 64 + (ch - 16) * 8;
            kstr[i] = (ch < 16) ? 64 * D : 64 * 64;
            kdst[i] = row * AT_KROW + ch * 16; }
        const bf16_t* vsrc[2]; int vdst[2];
#pragma unroll
        for (int i = 0; i < 2; ++i) { const int idx = tid + 512 * i, row = idx >> 3, ch = idx & 7;
            vsrc[i] = VT + (size_t)(h * 128 + row) * KVR + krow0 + ch * 8; vdst[i] = AT_KT + row * AT_VROW + ch * 16; }
        u32x4 ka_[3], va_[2], kb_[3], vb_[2];
#define AT_LOAD(KS, VS, t) do { _Pragma("unroll") for (int i = 0; i < 3; ++i) KS[i] = *(const u32x4*)(ksrc[i] + (size_t)(t) * kstr[i]); \
                                _Pragma("unroll") for (int i = 0; i < 2; ++i) VS[i] = *(const u32x4*)(vsrc[i] + (t) * 64); } while (0)
#define AT_STORE(KS, VS, off) do { _Pragma("unroll") for (int i = 0; i < 3; ++i) *(LAS u32x4*)(lds + (off) + kdst[i]) = KS[i]; \
                                   _Pragma("unroll") for (int i = 0; i < 2; ++i) *(LAS u32x4*)(lds + (off) + vdst[i]) = VS[i]; } while (0)
        AT_LOAD(kb_, vb_, 0);
        AT_LOAD(ka_, va_, 1);
        __syncthreads();
        AT_STORE(kb_, vb_, 0);
        __syncthreads();
        f32x4 o[8];
#pragma unroll
        for (int i = 0; i < 8; ++i) o[i] = (f32x4){0.f, 0.f, 0.f, 0.f};
        float m_run = -INFINITY, l_run = 0.f;
#define AT_STEP(cur) do { \
            f32x4 sc[4]; \
            _Pragma("unroll") for (int kb = 0; kb < 4; ++kb) { \
                f32x4 a = {0.f, 0.f, 0.f, 0.f}; \
                const LAS unsigned char* kp = lds + (cur) + (16 * kb + l15) * AT_KROW + g4 * 16; \
                _Pragma("unroll") for (int s = 0; s < 6; ++s) { const bf16x8 kf = *(const LAS bf16x8*)(kp + s * 64); a = __builtin_amdgcn_mfma_f32_16x16x32_bf16(kf, qf[s], a, 0, 0, 0); } \
                sc[kb] = a; } \
            float mx = fmaxf(fmaxf(sc[0][0], sc[0][1]), fmaxf(sc[0][2], sc[0][3])); \
            _Pragma("unroll") for (int kb = 1; kb < 4; ++kb) mx = fmaxf(mx, fmaxf(fmaxf(sc[kb][0], sc[kb][1]), fmaxf(sc[kb][2], sc[kb][3]))); \
            mx = xg_max(mx); \
            const float m_new = fmaxf(m_run, mx); \
            const float alpha = __builtin_amdgcn_exp2f(m_run - m_new); \
            m_run = m_new; \
            float ps = 0.f; \
            _Pragma("unroll") for (int kb = 0; kb < 4; ++kb) _Pragma("unroll") for (int i = 0; i < 4; ++i) { sc[kb][i] = __builtin_amdgcn_exp2f(sc[kb][i] - m_new); ps += sc[kb][i]; } \
            l_run = l_run * alpha + ps; \
            _Pragma("unroll") for (int i = 0; i < 8; ++i) o[i] *= alpha; \
            bf16x8 pf[2]; \
            _Pragma("unroll") for (int kp = 0; kp < 2; ++kp) { \
                u32x4 w; w.x = cvt_pk_bf16(sc[2 * kp][0], sc[2 * kp][1]); w.y = cvt_pk_bf16(sc[2 * kp][2], sc[2 * kp][3]); \
                w.z = cvt_pk_bf16(sc[2 * kp + 1][0], sc[2 * kp + 1][1]); w.w = cvt_pk_bf16(sc[2 * kp + 1][2], sc[2 * kp + 1][3]); \
                pf[kp] = __builtin_bit_cast(bf16x8, w); } \
            _Pragma("unroll") for (int db = 0; db < 8; ++db) { \
                const LAS unsigned char* vp = lds + (cur) + AT_KT + (16 * db + l15) * AT_VROW + g4 * 16; \
                _Pragma("unroll") for (int kp = 0; kp < 2; ++kp) { \
                    const bf16x8 vf = *(const LAS bf16x8*)(vp + kp * 64); \
                    o[db] = __builtin_amdgcn_mfma_f32_16x16x32_bf16(vf, pf[kp], o[db], 0, 0, 0); } } \
        } while (0)
        for (int t = 0; t < ntile; t += 2) {
            if (t + 2 < ntile) AT_LOAD(kb_, vb_, t + 2);
            AT_STEP(0);
            AT_STORE(ka_, va_, AT_STAGE);
            __syncthreads();
            if (t + 3 < ntile) AT_LOAD(ka_, va_, t + 3);
            AT_STEP(AT_STAGE);
            if (t + 2 < ntile) AT_STORE(kb_, vb_, 0);
            __syncthreads();
        }
#undef AT_LOAD
#undef AT_STORE
#undef AT_STEP
        const float inv = 1.0f / xg_sum(l_run);
        bf16_t* op = O + (size_t)(qrow0 + wave * 16 + l15) * D + h * 128 + 4 * g4;
#pragma unroll
        for (int db = 0; db < 8; ++db) { u32x2 w; w.x = cvt_pk_bf16(o[db][0] * inv, o[db][1] * inv); w.y = cvt_pk_bf16(o[db][2] * inv, o[db][3] * inv); *(u32x2*)(op + 16 * db) = w; }
    }
}

constexpr int S5_ROW = 288, S5_SUB = 16 * S5_ROW, S5_WAVE = 2 * S5_SUB + 2048, S5_FIN = 8 * S5_WAVE;
struct S5Consts { bf16x8 bfr[4]; bf16x8 cfr[4]; float ar[2], ai[2]; };
__device__ __forceinline__ void s5_consts(KA ka, int g, int d, int lane, S5Consts& K) {
    const int pl = lane & 31, hh = lane >> 5, l15 = lane & 15, g4 = lane >> 4;
    const float dt = expf(IN_(I_LOGDT)[d * 128 + g]);
#pragma unroll
    for (int s = 0; s < 2; ++s) {
        const int p = pl + 32 * s; const size_t pi = (size_t)(d * 128 + g) * 64 + p;
        const float lr = IN_(I_ARE)[pi], li = IN_(I_AIM)[pi];
        const float er = expf(lr * dt); float sn, cs; sincosf(li * dt, &sn, &cs);
        const float abr = er * cs, abi = er * sn;
        K.ar[s] = abr; K.ai[s] = abi;
        const float nr = abr - 1.0f, ni = abi, den = 1.0f / (lr * lr + li * li);
        const float cr = (nr * lr + ni * li) * den, ci = (ni * lr - nr * li) * den;
        const f32x4 b0 = *(const f32x4*)(IN_(I_BRE) + pi * 16 + 8 * hh), b1 = *(const f32x4*)(IN_(I_BRE) + pi * 16 + 8 * hh + 4);
        const f32x4 c0 = *(const f32x4*)(IN_(I_BIM) + pi * 16 + 8 * hh), c1 = *(const f32x4*)(IN_(I_BIM) + pi * 16 + 8 * hh + 4);
        u32x4 wr_, wi_;
        wr_.x = cvt_pk_bf16(cr * b0[0] - ci * c0[0], cr * b0[1] - ci * c0[1]); wr_.y = cvt_pk_bf16(cr * b0[2] - ci * c0[2], cr * b0[3] - ci * c0[3]);
        wr_.z = cvt_pk_bf16(cr * b1[0] - ci * c1[0], cr * b1[1] - ci * c1[1]); wr_.w = cvt_pk_bf16(cr * b1[2] - ci * c1[2], cr * b1[3] - ci * c1[3]);
        wi_.x = cvt_pk_bf16(cr * c0[0] + ci * b0[0], cr * c0[1] + ci * b0[1]); wi_.y = cvt_pk_bf16(cr * c0[2] + ci * b0[2], cr * c0[3] + ci * b0[3]);
        wi_.z = cvt_pk_bf16(cr * c1[0] + ci * b1[0], cr * c1[1] + ci * b1[1]); wi_.w = cvt_pk_bf16(cr * c1[2] + ci * b1[2], cr * c1[3] + ci * b1[3]);
        K.bfr[s] = __builtin_bit_cast(bf16x8, wr_); K.bfr[2 + s] = __builtin_bit_cast(bf16x8, wi_);
    }
#pragma unroll
    for (int ks = 0; ks < 4; ++ks) {
        const size_t ci = ((size_t)(d * 128 + g) * 16 + l15) * 64 + 16 * ks + 4 * g4;
        const f32x4 cr = *(const f32x4*)(IN_(I_CRE) + ci), cm = *(const f32x4*)(IN_(I_CIM) + ci);
        u32x4 w; w.x = cvt_pk_bf16(cr[0], -cm[0]); w.y = cvt_pk_bf16(cr[1], -cm[1]); w.z = cvt_pk_bf16(cr[2], -cm[2]); w.w = cvt_pk_bf16(cr[3], -cm[3]);
        K.cfr[ks] = __builtin_bit_cast(bf16x8, w);
    }
}
template <int MODE, bool BWD>
__device__ __forceinline__ void s5_pass(KA ka, int lane, int g, int rowb0, int rowb1, int nchunk, const S5Consts& K, bf16x8 dfr, float (&hr)[2], float (&hi)[2], LAS unsigned char* hsb) {
    const int pl = lane & 31, hh = lane >> 5, l15 = lane & 15, g4 = lane >> 4;
    const bf16_t* H = (const bf16_t*)(WS_ + WS_H); float* YS = (float*)(WS_ + WS_YST); bf16_t* G = (bf16_t*)(WS_ + WS_G);
    const int a_sub = (pl >> 2) & 1, a_idx = 4 * (pl >> 3) + (pl & 3);
    const bf16_t* ap = H + (size_t)((a_sub ? rowb1 : rowb0) + a_idx) * D + g * 16 + 8 * hh;
    const int t_first = BWD ? 16 * (nchunk - 1) : 0, t_step = BWD ? -16 : 16;
    bf16x8 a_cur = *(const bf16x8*)(ap + (size_t)t_first * D);
    float xr[2] = {hr[0], hr[1]}, xi[2] = {hi[0], hi[1]};
#pragma unroll 1
    for (int c = 0; c < nchunk; ++c) {
        const int t0 = t_first + c * t_step;
        bf16x8 a_nxt = a_cur;
        if (c + 1 < nchunk) a_nxt = *(const bf16x8*)(ap + (size_t)(t0 + t_step) * D);
        float st[2][4]; bf16x8 ua[2];
        if (MODE == 2) {
#pragma unroll
            for (int sb = 0; sb < 2; ++sb) {
                const int rb = (sb ? rowb1 : rowb0) + t0;
#pragma unroll
                for (int i = 0; i < 4; ++i) st[sb][i] = __hip_atomic_load(YS + ((size_t)g * MT + rb + 4 * g4 + i) * 16 + l15, __ATOMIC_RELAXED, __HIP_MEMORY_SCOPE_AGENT);
                const u32x4 z = {0u, 0u, 0u, 0u};
                ua[sb] = __builtin_bit_cast(bf16x8, z);
                if (g4 < 2) ua[sb] = *(const bf16x8*)(H + (size_t)(rb + l15) * D + g * 16 + 8 * g4);
            }
        }
        const f32x16 z16 = {0.f,0.f,0.f,0.f,0.f,0.f,0.f,0.f,0.f,0.f,0.f,0.f,0.f,0.f,0.f,0.f};
#pragma unroll
        for (int s = 0; s < 2; ++s) {
            const f32x16 br_ = __builtin_amdgcn_mfma_f32_32x32x16_bf16(a_cur, K.bfr[s], z16, 0, 0, 0);
            const f32x16 bi_ = __builtin_amdgcn_mfma_f32_32x32x16_bf16(a_cur, K.bfr[2 + s], z16, 0, 0, 0);
            f32x2 x = {xr[s], xi[s]}; const f32x2 ca = {K.ar[s], K.ar[s]}, cb = {-K.ai[s], K.ai[s]};
            LAS unsigned* hw = (LAS unsigned*)(hsb + hh * S5_SUB) + pl + 32 * s;
#pragma unroll
            for (int ii = 0; ii < 16; ++ii) {
                const int i = BWD ? 15 - ii : ii;
                const f32x2 u = {br_[i], bi_[i]}; const f32x2 xs = {x.y, x.x};
                x = ca * x + (cb * xs + u);
                if (MODE != 0) hw[i * (S5_ROW / 4)] = cvt_pk_bf16(x.x, x.y);
            }
            xr[s] = x.x; xi[s] = x.y;
        }
        if (MODE != 0) {
            asm volatile("s_waitcnt lgkmcnt(0)" ::: "memory");
            f32x4 y[2];
#pragma unroll
            for (int sb = 0; sb < 2; ++sb) {
                f32x4 a = {0.f, 0.f, 0.f, 0.f};
                const LAS unsigned char* hp = hsb + sb * S5_SUB + l15 * S5_ROW + g4 * 16;
#pragma unroll
                for (int ks = 0; ks < 4; ++ks) { const bf16x8 hf = *(const LAS bf16x8*)(hp + ks * 64); a = __builtin_amdgcn_mfma_f32_16x16x32_bf16(hf, K.cfr[ks], a, 0, 0, 0); }
                if (MODE == 2) a = __builtin_amdgcn_mfma_f32_16x16x32_bf16(ua[sb], dfr, a, 0, 0, 0);
                y[sb] = a;
            }
            if (MODE == 1) {
#pragma unroll
                for (int sb = 0; sb < 2; ++sb) { const int rb = (sb ? rowb1 : rowb0) + t0;
#pragma unroll
                    for (int i = 0; i < 4; ++i) YS[((size_t)g * MT + rb + 4 * g4 + i) * 16 + l15] = y[sb][i]; }
            } else {
                LAS float* tl = (LAS float*)(hsb + 2 * S5_SUB);
#pragma unroll
                for (int sb = 0; sb < 2; ++sb)
#pragma unroll
                    for (int i = 0; i < 4; ++i) tl[sb * 256 + (4 * g4 + i) * 16 + l15] = gelu_tanh_f(y[sb][i] + st[sb][i]);
                asm volatile("s_waitcnt lgkmcnt(0)" ::: "memory");
                const int tt = pl >> 1, hf = pl & 1;
                const f32x4 o0 = *(const LAS f32x4*)(tl + hh * 256 + tt * 16 + hf * 8), o1 = *(const LAS f32x4*)(tl + hh * 256 + tt * 16 + hf * 8 + 4);
                u32x4 o; o.x = cvt_pk_bf16(o0[0], o0[1]); o.y = cvt_pk_bf16(o0[2], o0[3]); o.z = cvt_pk_bf16(o1[0], o1[1]); o.w = cvt_pk_bf16(o1[2], o1[3]);
                *(u32x4*)(G + (size_t)((hh ? rowb1 : rowb0) + t0 + tt) * D + g * 16 + 8 * hf) = o;
                asm volatile("s_waitcnt lgkmcnt(0)" ::: "memory");
            }
        }
        a_cur = a_nxt;
    }
    if (MODE == 1) asm volatile("s_waitcnt vmcnt(0)" ::: "memory");
    hr[0] = xr[0]; hr[1] = xr[1]; hi[0] = xi[0]; hi[1] = xi[1];
}
__device__ __forceinline__ bf16x8 s5_dfr(KA ka, int g, int lane) {
    const int l15 = lane & 15, g4 = lane >> 4; const float dk = IN_(I_S5D)[g * 16 + l15];
    u32x4 w;
    w.x = cvt_pk_bf16((8 * g4 + 0 == l15) ? dk : 0.f, (8 * g4 + 1 == l15) ? dk : 0.f); w.y = cvt_pk_bf16((8 * g4 + 2 == l15) ? dk : 0.f, (8 * g4 + 3 == l15) ? dk : 0.f);
    w.z = cvt_pk_bf16((8 * g4 + 4 == l15) ? dk : 0.f, (8 * g4 + 5 == l15) ? dk : 0.f); w.w = cvt_pk_bf16((8 * g4 + 6 == l15) ? dk : 0.f, (8 * g4 + 7 == l15) ? dk : 0.f);
    return __builtin_bit_cast(bf16x8, w);
}
__device__ __forceinline__ void phase_s5(Frame& F) {
    KA ka = get_ka();
    const int lane = F.lane, wave = F.wave, pl = lane & 31, hh = lane >> 5;
    LAS unsigned char* hsb = F.lds + wave * S5_WAVE;
    if (F.vcu < 128) {
        const int g = F.vcu;
        LAS float* fin = (LAS float*)(F.lds + S5_FIN);
        const int rowb0 = MCTX + 128 * wave, rowb1 = MCTX + 1024 + 128 * wave;
        const bf16x8 dfr = s5_dfr(ka, g, lane);
#pragma unroll 1
        for (int d = 0; d < 2; ++d) {
            S5Consts K; s5_consts(ka, g, d, lane, K);
            float hr[2] = {0.f, 0.f}, hi[2] = {0.f, 0.f};
            if (d == 0) s5_pass<0, false>(ka, lane, g, rowb0, rowb1, 8, K, dfr, hr, hi, hsb);
            else s5_pass<0, true>(ka, lane, g, rowb0, rowb1, 8, K, dfr, hr, hi, hsb);
#pragma unroll
            for (int s = 0; s < 2; ++s) { LAS float* fp = fin + (((d * 8 + wave) * 2 + hh) * 64 + pl + 32 * s) * 2; fp[0] = hr[s]; fp[1] = hi[s]; }
        }
        __syncthreads();
#pragma unroll 1
        for (int d = 0; d < 2; ++d) {
            S5Consts K; s5_consts(ka, g, d, lane, K);
            float hr[2], hi[2];
#pragma unroll
            for (int s = 0; s < 2; ++s) {
                float pr = K.ar[s], pi_ = K.ai[s];
#pragma unroll
                for (int q = 0; q < 7; ++q) { const float nr = pr * pr - pi_ * pi_, ni = 2.0f * pr * pi_; pr = nr; pi_ = ni; }
                const size_t si = ((size_t)(hh * 2 + d) * 128 + g) * 64 + pl + 32 * s;
                float cr = IN_(I_SRE)[si], ci = IN_(I_SIM)[si];
#pragma unroll 1
                for (int q = 0; q < 7; ++q) {
                    const int sg = d ? 7 - q : q;
                    const bool take = d ? (sg > wave) : (sg < wave);
                    const LAS float* fp = fin + (((d * 8 + sg) * 2 + hh) * 64 + pl + 32 * s) * 2;
                    const float fr = fp[0], fi = fp[1];
                    const float nr = pr * cr - pi_ * ci + fr, ni = pr * ci + pi_ * cr + fi;
                    if (take) { cr = nr; ci = ni; }
                }
                hr[s] = cr; hi[s] = ci;
            }
            if (d == 0) s5_pass<1, false>(ka, lane, g, rowb0, rowb1, 8, K, dfr, hr, hi, hsb);
            else s5_pass<2, true>(ka, lane, g, rowb0, rowb1, 8, K, dfr, hr, hi, hsb);
        }
        __syncthreads();
        convert_slot(F, ka, 6, F.vcu * 8 + wave, 128 * 8);
    } else {
#pragma unroll 1
        for (int item = (F.vcu - 128) * 8 + wave; item < 1024; item += (F.G - 128) * 8) {
            const int g = item >> 3, pr_ = item & 7;
            const int rowb0 = (2 * pr_) * 256, rowb1 = (2 * pr_ + 1) * 256;
            const bf16x8 dfr = s5_dfr(ka, g, lane);
#pragma unroll 1
            for (int d = 0; d < 2; ++d) {
                S5Consts K; s5_consts(ka, g, d, lane, K);
                float hr[2] = {0.f, 0.f}, hi[2] = {0.f, 0.f};
                if (d == 0) s5_pass<1, false>(ka, lane, g, rowb0, rowb1, 16, K, dfr, hr, hi, hsb);
                else s5_pass<2, true>(ka, lane, g, rowb0, rowb1, 16, K, dfr, hr, hi, hsb);
#pragma unroll
                for (int s = 0; s < 2; ++s) { const size_t si = ((size_t)((2 * pr_ + hh) * 2 + d) * 128 + g) * 64 + pl + 32 * s; OUT_[OUT_SRE + si] = hr[s]; OUT_[OUT_SIM + si] = hi[s]; }
            }
        }
    }
}

constexpr int NPH = 23;

__device__ __forceinline__ void gemm_ffn_in(Frame& F, int fi) {
    KA ka = get_ka();
    pg8::Gemm g{(const bf16_t*)(WS_ + WS_H), (const bf16_t*)(WS_ + WS_WIN) + (size_t)fi * NFF2 * D, MT, NFF2, D};
#ifndef G1_MB
#define G1_MB 4
#endif
    pg8::EpiSwiGLU E{(bf16_t*)(WS_ + WS_ACT)};
    if (fi == 3) {
        pg8::Ffn3MainOrder S1{F.G, (int)blockIdx.x};
        pg8::gemm_phase<pg8::EpiSwiGLU, pg8::Ffn3MainOrder, true, true, 3>(F.lds, g, S1, E);
        if (F.vcu < 192) { pg8::Ffn3TailOrder S2{F.vcu}; pg8::gemm_phase<pg8::EpiSwiGLU, pg8::Ffn3TailOrder, true, true, 2>(F.lds, g, S2, E); }
        else convert_slot(F, ka, 5, (F.vcu - 192) * 8 + F.wave, (F.G - 192) * 8);
        return;
    }
    pg8::StaticOrder S; S.init(MT, NFF2, F.G, (int)blockIdx.x, 192);
    pg8::gemm_phase<pg8::EpiSwiGLU, pg8::StaticOrder, true, true, 3>(F.lds, g, S, E);
    if ((int)blockIdx.x >= 128) convert_slot(F, ka, fi == 0 ? 1 : fi + 2, ((int)blockIdx.x - 128) * 8 + F.wave, (F.G - 128) * 8);
}
__device__ __forceinline__ void gemm_ffn_out(Frame& F, int l, int sub, bool first_sub) {
    KA ka = get_ka();
    const int fi = l * 2 + (sub == 2 ? 1 : 0);
    bf16_t* X = (bf16_t*)(WS_ + WS_X);
    pg8::Gemm g{(const bf16_t*)(WS_ + WS_ACT), (const bf16_t*)(WS_ + WS_WOUT) + (size_t)fi * D * DFF, MT, D, DFF};
    pg8::StaticOrder S; S.init(MT, D, F.G, (int)blockIdx.x, 192);
    if (first_sub) {
        pg8::EpiResT<true> E{IN_(I_XP), IN_(I_XS) - (size_t)MCTX * D, X, MODS_ + (size_t)l * 3 * NMOD + (sub * 3 + 2) * D, 0.5f};
        pg8::gemm_phase<pg8::EpiResT<true>, pg8::StaticOrder, true, true, 3>(F.lds, g, S, E);
    } else {
        pg8::EpiResT<false> E{X, X, X, MODS_ + (size_t)l * 3 * NMOD + (sub * 3 + 2) * D, 0.5f};
        pg8::gemm_phase<pg8::EpiResT<false>, pg8::StaticOrder, true, true, 3>(F.lds, g, S, E);
    }
}
__device__ __forceinline__ void gemm_wo(Frame& F) {
    KA ka = get_ka();
    bf16_t* X = (bf16_t*)(WS_ + WS_X);
    pg8::Gemm g{(const bf16_t*)(WS_ + WS_O), (const bf16_t*)(WS_ + WS_WO), MT, D, D};
    pg8::StaticOrder S; S.init(MT, D, F.G, (int)blockIdx.x, 192);
    pg8::EpiResT<false> E{X, X, X, MODS_ + (size_t)(1 * 3 + 2) * D, 1.0f};
    pg8::gemm_phase<pg8::EpiResT<false>, pg8::StaticOrder, true, true, 3>(F.lds, g, S, E);
}
__device__ __forceinline__ void gemm_ga(Frame& F) {
    KA ka = get_ka();
    pg8::Gemm g{(const bf16_t*)(WS_ + WS_H), (const bf16_t*)(WS_ + WS_WA), MT, NA, D};
    pg8::StaticOrder S; S.init(MT, NA, F.G, (int)blockIdx.x, 192);
    pg8::EpiF32 E{(bf16_t*)(WS_ + WS_CQKV), NA};
    pg8::gemm_phase<pg8::EpiF32, pg8::StaticOrder, true, true, 3>(F.lds, g, S, E);
    if ((int)blockIdx.x >= 192) convert_slot(F, ka, 2, ((int)blockIdx.x - 192) * 8 + F.wave, (F.G - 192) * 8);
}
__device__ __forceinline__ void gemm_q(Frame& F) {
    KA ka = get_ka();
    pg8::Gemm g{(const bf16_t*)(WS_ + WS_CQ), (const bf16_t*)(WS_ + WS_WUQ), MT, NQ, QL};
    pg8::StaticOrder S; S.init(MT, NQ, F.G, (int)blockIdx.x);
    pg8::EpiQ E{(bf16_t*)(WS_ + WS_Q), ROPEC_, ROPES_};
    pg8::gemm_phase<pg8::EpiQ, pg8::StaticOrder, true, true>(F.lds, g, S, E);
}
__device__ __forceinline__ void gemm_kn(Frame& F) {
    KA ka = get_ka();
    pg8::Gemm g{(const bf16_t*)(WS_ + WS_CKV), (const bf16_t*)(WS_ + WS_WUK), KVR, D, KVL};
    pg8::StaticOrder S; S.init(KVR, D, F.G, (int)((blockIdx.x + 224) % F.G));
    pg8::EpiBf16 E{(bf16_t*)(WS_ + WS_KN), D};
    pg8::gemm_phase<pg8::EpiBf16, pg8::StaticOrder, true, true>(F.lds, g, S, E);
}
__device__ __forceinline__ void gemm_vt(Frame& F) {
    KA ka = get_ka();
    pg8::Gemm g{(const bf16_t*)(WS_ + WS_WUV), (const bf16_t*)(WS_ + WS_CKV), D, KVR, KVL};
    pg8::StaticOrder S; S.init(D, KVR, F.G, (int)((blockIdx.x + 208) % F.G));
    pg8::EpiBf16 E{(bf16_t*)(WS_ + WS_VT), KVR};
    pg8::gemm_phase<pg8::EpiBf16, pg8::StaticOrder, true, true>(F.lds, g, S, E);
}
__device__ __forceinline__ void gemm_glu(Frame& F) {
    KA ka = get_ka();
    bf16_t* X = (bf16_t*)(WS_ + WS_X);
    pg8::Gemm g{(const bf16_t*)(WS_ + WS_G), (const bf16_t*)(WS_ + WS_WGLU), MT, 4096, D};
    pg8::StaticOrder S; S.init(MT, 4096, F.G, (int)blockIdx.x, 192);
    pg8::EpiGLU E{X, X, MODS_ + (size_t)1 * 3 * NMOD + (1 * 3 + 2) * D};
    pg8::gemm_phase<pg8::EpiGLU, pg8::StaticOrder, true, true, 3>(F.lds, g, S, E);
}

__global__ void __launch_bounds__(512, 2) mk_fwd(Args args) {
    extern __shared__ __attribute__((aligned(16))) unsigned char lds_raw[];
    Frame F;
    F.lds = (LAS unsigned char*)lds_raw;
    F.tid = threadIdx.x; F.lane = F.tid & 63; F.wave = __builtin_amdgcn_readfirstlane(F.tid >> 6);
    F.G = gridDim.x; { const int bx = blockIdx.x; F.vcu = (F.G % 8 == 0) ? (bx % 8) * (F.G / 8) + bx / 8 : bx; }
    volatile LAS unsigned* MISC = (volatile LAS unsigned*)(F.lds + MISC_OFF);
    if (F.tid < 32) MISC[F.tid] = 0u;
    __syncthreads();
    const int lo = args.ph_lo, hi = args.ph_hi; const bool use_bar = args.use_bar != 0;
    XcdBarrier bar; bar.bar = (unsigned*)(args.ws + WS_CTL) + 1024; bar.x = 0; bar.st = nullptr;
    if (use_bar) bar = xcd_barrier_post((unsigned*)(args.ws + WS_CTL) + 1024, MISC + 8);
#define IN(k) (lo <= (k) && (k) < hi)
#define SEAM(k) do { if ((k) + 1 < hi) { if (use_bar) xcd_barrier(bar); else __syncthreads(); } } while (0)
#ifndef REP_PH
#define REP_PH -1
#define REP_N 0
#endif
#define PHASE(k, body) do { if (IN(k)) { for (int r_ = 0; r_ < ((k) == REP_PH ? REP_N : 0); ++r_) { body; if (use_bar) xcd_barrier(bar); else __syncthreads(); } body; SEAM(k); } } while (0)
    PHASE(0, phase_prologue(F));
    PHASE(1, phase_norm(F, 0, 0, true));
    PHASE(2, gemm_ffn_in(F, 0));
    PHASE(3, gemm_ffn_out(F, 0, 0, true));
    PHASE(4, phase_norm(F, 0, 1, false));
    PHASE(5, gemm_ga(F));
    PHASE(6, phase_mla_norm(F));
    PHASE(7, { gemm_q(F); gemm_kn(F); gemm_vt(F); });
    PHASE(8, phase_attn(F));
    PHASE(9, gemm_wo(F));
    PHASE(10, phase_norm(F, 0, 2, false));
    PHASE(11, gemm_ffn_in(F, 1));
    PHASE(12, gemm_ffn_out(F, 0, 2, false));
    PHASE(13, phase_norm(F, 1, 0, false));
    PHASE(14, gemm_ffn_in(F, 2));
    PHASE(15, gemm_ffn_out(F, 1, 0, false));
    PHASE(16, phase_norm(F, 1, 1, false));
    PHASE(17, phase_s5(F));
    PHASE(18, gemm_glu(F));
    PHASE(19, phase_norm(F, 1, 2, false));
    PHASE(20, gemm_ffn_in(F, 3));
    PHASE(21, gemm_ffn_out(F, 1, 2, false));
    PHASE(22, phase_final(F));
#undef IN
#undef SEAM
#undef PHASE
}

extern "C" void kernel_launch(void* const* d_in, const int* in_sizes, int n_in, void* d_out, int out_size, void* d_ws, size_t ws_size, hipStream_t stream) {
    static int grid = 0;
    if (grid == 0) {
        if (n_in != 30 || ws_size < WS_END) { fprintf(stderr, "kernel_launch: unexpected n_in %d / ws_size %zu\n", n_in, ws_size); grid = -1; return; }
        int dev = 0, cus = 0, per_cu = 0;
        if (hipGetDevice(&dev) != hipSuccess || hipDeviceGetAttribute(&cus, hipDeviceAttributeMultiprocessorCount, dev) != hipSuccess) { grid = -1; return; }
        if (hipFuncSetAttribute((const void*)mk_fwd, hipFuncAttributeMaxDynamicSharedMemorySize, LDS_BYTES) != hipSuccess) { fprintf(stderr, "kernel_launch: hipFuncSetAttribute failed\n"); grid = -1; return; }
        if (hipOccupancyMaxActiveBlocksPerMultiprocessor(&per_cu, (const void*)mk_fwd, 512, LDS_BYTES) != hipSuccess || per_cu < 1) { fprintf(stderr, "kernel_launch: occupancy query says %d blocks per CU\n", per_cu); per_cu = 1; }
        (void)hipGetLastError();
        grid = cus;
    }
    if (grid < 0) return;
    (void)hipMemsetAsync((char*)d_ws + WS_CTL, 0, CTL_ZERO_BYTES, stream);
    Args a{};
    for (int i = 0; i < 30; ++i) a.in[i] = (const float*)d_in[i];
    a.out = (float*)d_out; a.ws = (unsigned char*)d_ws;
#if MK_PER_PHASE
    for (int ph = 0; ph < NPH; ++ph) {
        a.ph_lo = ph; a.ph_hi = ph + 1; a.use_bar = 0;
        hipLaunchKernelGGL(mk_fwd, dim3(grid), dim3(512), LDS_BYTES, stream, a);
    }
#else
    a.ph_lo = 0; a.ph_hi = NPH; a.use_bar = 1;
    void* kargs[] = {&a};
    hipError_t e = hipLaunchCooperativeKernel((const void*)mk_fwd, dim3(grid), dim3(512), kargs, LDS_BYTES, stream);
    if (e != hipSuccess) fprintf(stderr, "kernel_launch: cooperative launch failed: %s (grid %d)\n", hipGetErrorString(e), grid);
#endif
}
```

```cpp
#include <hip/hip_runtime.h>
#include <cstdio>
#include <cstdint>

#ifndef MK_PER_PHASE
#define MK_PER_PHASE 0
#endif

#define LAS __attribute__((address_space(3)))
#define GAS __attribute__((address_space(1)))
typedef unsigned short bf16_t;
typedef short bf16x8 __attribute__((ext_vector_type(8)));
typedef short bf16x4 __attribute__((ext_vector_type(4)));
typedef float f32x4 __attribute__((ext_vector_type(4)));
typedef float f32x2 __attribute__((ext_vector_type(2)));
typedef float f32x16 __attribute__((ext_vector_type(16)));
typedef unsigned u32x4 __attribute__((ext_vector_type(4)));
typedef unsigned u32x2 __attribute__((ext_vector_type(2)));

constexpr int D = 2048, MT = 6144, MCTX = 4096, DFF = 5632, NFF2 = 11264, NMOD = 18432;
constexpr int KVR = 6656;
constexpr int NQ = 3072, NA = 1536, QL = 768, KVL = 512;
constexpr float EPS = 1e-6f;
constexpr float QSCALE = 0.07216878364870322f * 1.4426950408889634f;

constexpr size_t MiB = 1u << 20;
constexpr size_t WS_CTL = 0, CTL_ZERO_BYTES = 64 * 1024;
constexpr size_t WS_MODS = 1 * MiB;
constexpr size_t WS_ROPE = 2 * MiB;
constexpr size_t WS_WIN = 16 * MiB;
constexpr size_t WS_WOUT = 192 * MiB;
constexpr size_t WS_WA = 280 * MiB;
constexpr size_t WS_WUQ = 286 * MiB;
constexpr size_t WS_WUK = 291 * MiB;
constexpr size_t WS_WUV = 293 * MiB;
constexpr size_t WS_WO = 295 * MiB;
constexpr size_t WS_WGLU = 303 * MiB;
constexpr size_t WS_X = 320 * MiB;
constexpr size_t WS_H = 368 * MiB;
constexpr size_t WS_ACT = 392 * MiB;
constexpr size_t WS_CQKV = 458 * MiB;
constexpr size_t WS_CQ = 494 * MiB;
constexpr size_t WS_CKV = 503 * MiB;
constexpr size_t WS_KPE = 510 * MiB;
constexpr size_t WS_Q = 511 * MiB;
constexpr size_t WS_KN = 547 * MiB;
constexpr size_t WS_VT = 573 * MiB;
constexpr size_t WS_O = 599 * MiB;
constexpr size_t WS_YST = 623 * MiB;
constexpr size_t WS_G = 671 * MiB;
constexpr size_t WS_END = 696 * MiB;

constexpr size_t OUT_Y = 0, OUT_CKV = 12582912, OUT_KPE = 14680064, OUT_SRE = 14942208, OUT_SIM = 15204352;

constexpr int LDS_BYTES = 147456;
constexpr int MISC_OFF = 131072 + 320;

typedef __bf16 bf16x2_t __attribute__((ext_vector_type(2)));
__device__ __forceinline__ unsigned cvt_pk_bf16(float lo, float hi) { const f32x2 v = {lo, hi}; const bf16x2_t b = __builtin_convertvector(v, bf16x2_t); return __builtin_bit_cast(unsigned, b); }
__device__ __forceinline__ float wave_sum(float v) {
#pragma unroll
    for (int o = 1; o < 64; o <<= 1) v += __shfl_xor(v, o);
    return v;
}
__device__ __forceinline__ float silu_f(float v) { return v * __builtin_amdgcn_rcpf(1.0f + __expf(-v)); }
__device__ __forceinline__ float sigmoid_f(float v) { return __builtin_amdgcn_rcpf(1.0f + __expf(-v)); }
__device__ __forceinline__ float gelu_tanh_f(float x) {
    const float k0 = -2.0f * 0.7978845608028654f * 1.4426950408889634f, k1 = k0 * 0.044715f;
    const float t = x * x;
    return x * __builtin_amdgcn_rcpf(1.0f + __builtin_amdgcn_exp2f(x * (k0 + k1 * t)));
}
__device__ __forceinline__ int tile_ms(int pm) { return pm < 16 ? 0 : 1 + ((pm - 16) >> 2); }

namespace pg8 {
constexpr int BM = 256, BK = 64, HALF = 128, HTB = HALF * BK * 2, STAGE_BYTES = 8 * HTB, NXCD = 8, WGM = 8;
__host__ __device__ __forceinline__ int lds_byte(int r, int c) { const int st = (r >> 4) * 2 + (c >> 5), rr = r & 15, cc = c & 31, ob = rr * 64 + cc * 2; return st * 1024 + (ob ^ (((ob >> 9) & 1) << 5)); }
__host__ __device__ __forceinline__ void stage_rc(int b, int& R, int& C) { const int st = b / 1024, sb = b % 1024, swz = sb ^ (((sb >> 9) & 1) << 5); R = (st >> 1) * 16 + swz / 64; C = (st & 1) * 32 + (swz % 64) / 2; }
__host__ __device__ __forceinline__ int perm32(int rho) { const int n = rho >> 4, i = rho & 15; return 8 * (i >> 2) + 4 * n + (i & 3); }

struct Unit { int pm, pn; };
struct Gemm { const bf16_t* A; const bf16_t* Bt; int M, N, K; };

struct StaticOrder {
    int nM, nN, nwg, G, c;
    __host__ __device__ void init(int M, int N, int G_, int c_, int rows = BM) { nM = M / rows; nN = N / BM; nwg = nM * nN; G = G_; c = c_; }
    __host__ __device__ bool next(int i, Unit& u) const {
        const long L = (long)i * G + c; if (L >= nwg) return false;
        int wgid = (int)L; { const int q = nwg / NXCD, r = nwg % NXCD, xcd = wgid % NXCD, off = wgid / NXCD; wgid = (xcd < r ? xcd * (q + 1) : r * (q + 1) + (xcd - r) * q) + off; }
        const int nig = WGM * nN, gid = wgid / nig, fm = gid * WGM, gsz = (nM - fm) < WGM ? (nM - fm) : WGM;
        u.pm = fm + ((wgid % nig) % gsz); u.pn = (wgid % nig) / gsz; return true;
    }
    __device__ __forceinline__ void a_ready(const Unit&) const {}
    __device__ __forceinline__ void done(const Unit&) const {}
};

struct FfnMainOrder {
    int G, c;
    __device__ bool next(int i, Unit& u) const {
        const int L = i * G + c; if (L >= 1024) return false;
        const int w0 = (L % NXCD) * 128 + L / NXCD;
        if (w0 < 704) { const int gid = w0 / 352, w = w0 % 352; u.pm = 8 * gid + (w & 7); u.pn = w >> 3; }
        else { const int w = w0 - 704; u.pm = 16 + (w & 7); u.pn = w >> 3; }
        return true;
    }
    __device__ __forceinline__ void a_ready(const Unit&) const {}
    __device__ __forceinline__ void done(const Unit&) const {}
};
struct FfnTail2Order {
    int c;
    __device__ bool next(int i, Unit& u) const { if (i > 0 || c >= 64) return false; u.pm = 32 + (c >> 2); u.pn = 40 + (c & 3); return true; }
    __device__ __forceinline__ void a_ready(const Unit&) const {}
    __device__ __forceinline__ void done(const Unit&) const {}
};
struct FfnTailOrder {
    int c;
    __device__ bool next(int i, Unit& u) const { if (i > 0 || c >= 128) return false; u.pm = 64 + (c >> 2); u.pn = 40 + (c & 3); return true; }
    __device__ __forceinline__ void a_ready(const Unit&) const {}
    __device__ __forceinline__ void done(const Unit&) const {}
};

struct Ffn3MainOrder {
    int G, c;
    __device__ bool next(int i, Unit& u) const {
        const int L = i * G + c; if (L >= 1280) return false;
        const int w0 = (L % NXCD) * 160 + L / NXCD;
        const int gid = w0 / 320, w = w0 % 320; u.pm = 8 * gid + (w & 7); u.pn = w >> 3; return true;
    }
    __device__ __forceinline__ void a_ready(const Unit&) const {}
    __device__ __forceinline__ void done(const Unit&) const {}
};
struct Ffn3TailOrder {
    int c;
    __device__ bool next(int i, Unit& u) const { if (i > 0 || c >= 192) return false; u.pm = c >> 2; u.pn = 40 + (c & 3); return true; }
    __device__ __forceinline__ void a_ready(const Unit&) const {}
    __device__ __forceinline__ void done(const Unit&) const {}
};


struct EpiSwiGLU {
    static constexpr bool PERM = true, AFTER_DRAIN = false;
    bf16_t* O;
    template <int MB>
    __device__ __forceinline__ void operator()(const f32x4 (&acc)[2][2][MB][2], const Unit& u, int wr, int wc, int fr, int fq) const {
        const int row0 = u.pm * 64 * MB + wr * 16 * MB + fr, col0 = u.pn * HALF + wc * 32 + 8 * fq;
#pragma unroll
        for (int ai = 0; ai < 2; ++ai)
#pragma unroll
            for (int m = 0; m < MB; ++m) {
                bf16_t* rowp = O + (size_t)(row0 + ai * 32 * MB + m * 16) * DFF + col0;
                const f32x4 g0 = acc[ai][0][m][0], g1 = acc[ai][0][m][1], u0 = acc[ai][1][m][0], u1 = acc[ai][1][m][1];
                f32x4 v0, v1;
#pragma unroll
                for (int j = 0; j < 4; ++j) { v0[j] = silu_f(g0[j]) * u0[j]; v1[j] = silu_f(g1[j]) * u1[j]; }
                u32x4 w; w.x = cvt_pk_bf16(v0[0], v0[1]); w.y = cvt_pk_bf16(v0[2], v0[3]); w.z = cvt_pk_bf16(v1[0], v1[1]); w.w = cvt_pk_bf16(v1[2], v1[3]);
                *(u32x4*)rowp = w;
            }
    }
};
__device__ __forceinline__ f32x4 bf4_f4(u32x2 r) { f32x4 o; o[0] = __uint_as_float(r.x << 16); o[1] = __uint_as_float(r.x & 0xffff0000u); o[2] = __uint_as_float(r.y << 16); o[3] = __uint_as_float(r.y & 0xffff0000u); return o; }
__device__ __forceinline__ int row_ms(int row) { return row < MCTX ? 0 : 1 + ((row - MCTX) >> 10); }
template <bool XF32>
struct EpiResT {
    static constexpr bool PERM = false, AFTER_DRAIN = false;
    const void* xa; const void* xb; bf16_t* xo; const float* gate; float coef;
    template <int MB>
    __device__ __forceinline__ void operator()(const f32x4 (&acc)[2][2][MB][2], const Unit& u, int wr, int wc, int fr, int fq) const {
        const int row0 = u.pm * 64 * MB + wr * 16 * MB + fr, col0 = u.pn * BM + wc * 32 + 4 * fq;
        const int ms0 = row_ms(u.pm * 64 * MB); const bool uni = ms0 == row_ms(u.pm * 64 * MB + 64 * MB - 1);
        f32x4 g0[2][2];
#pragma unroll
        for (int bj = 0; bj < 2; ++bj)
#pragma unroll
            for (int n = 0; n < 2; ++n) g0[bj][n] = *(const f32x4*)(gate + ms0 * NMOD + col0 + bj * HALF + n * 16) * coef;
        f32x4 xf[XF32 ? 2 : 1][XF32 ? MB : 1][2][2]; u32x2 xh[XF32 ? 1 : 2][XF32 ? 1 : MB][2][2];
#pragma unroll
        for (int ai = 0; ai < 2; ++ai)
#pragma unroll
            for (int m = 0; m < MB; ++m) {
                const int row = row0 + ai * 32 * MB + m * 16; const void* xin = (row < MCTX) ? xa : xb;
                const size_t off = (size_t)row * D + col0;
#pragma unroll
                for (int bj = 0; bj < 2; ++bj)
#pragma unroll
                    for (int n = 0; n < 2; ++n) {
                        if constexpr (XF32) xf[ai][m][bj][n] = *(const f32x4*)((const float*)xin + off + bj * HALF + n * 16);
                        else xh[ai][m][bj][n] = *(const u32x2*)((const bf16_t*)xin + off + bj * HALF + n * 16); }
            }
#pragma unroll
        for (int ai = 0; ai < 2; ++ai)
#pragma unroll
            for (int m = 0; m < MB; ++m) {
                const int row = row0 + ai * 32 * MB + m * 16;
                const float* gv = gate + row_ms(row) * NMOD;
                const size_t off = (size_t)row * D + col0;
#pragma unroll
                for (int bj = 0; bj < 2; ++bj)
#pragma unroll
                    for (int n = 0; n < 2; ++n) { f32x4 gt = g0[bj][n]; if (!uni) gt = *(const f32x4*)(gv + col0 + bj * HALF + n * 16) * coef;
                        f32x4 xi; if constexpr (XF32) xi = xf[ai][m][bj][n]; else xi = bf4_f4(xh[ai][m][bj][n]);
                        const f32x4 o = xi + gt * acc[ai][bj][m][n];
                        u32x2 w; w.x = cvt_pk_bf16(o[0], o[1]); w.y = cvt_pk_bf16(o[2], o[3]);
                        *(u32x2*)(xo + off + bj * HALF + n * 16) = w; }
            }
    }
};
struct EpiGLU {
    static constexpr bool PERM = false, AFTER_DRAIN = false;
    const bf16_t* xin; bf16_t* xo; const float* gate;
    template <int MB>
    __device__ __forceinline__ void operator()(const f32x4 (&acc)[2][2][MB][2], const Unit& u, int wr, int wc, int fr, int fq) const {
        const int row0 = u.pm * 64 * MB + wr * 16 * MB + fr, col0 = u.pn * HALF + wc * 32 + 4 * fq;
        const int ms0 = row_ms(u.pm * 64 * MB); const bool uni = ms0 == row_ms(u.pm * 64 * MB + 64 * MB - 1);
        f32x4 g0[2];
#pragma unroll
        for (int n = 0; n < 2; ++n) g0[n] = *(const f32x4*)(gate + ms0 * NMOD + col0 + n * 16);
        u32x2 xi[2][MB][2];
#pragma unroll
        for (int ai = 0; ai < 2; ++ai)
#pragma unroll
            for (int m = 0; m < MB; ++m)
#pragma unroll
                for (int n = 0; n < 2; ++n) xi[ai][m][n] = *(const u32x2*)(xin + (size_t)(row0 + ai * 32 * MB + m * 16) * D + col0 + n * 16);
#pragma unroll
        for (int ai = 0; ai < 2; ++ai)
#pragma unroll
            for (int m = 0; m < MB; ++m) {
                const int row = row0 + ai * 32 * MB + m * 16;
                const float* gv = gate + row_ms(row) * NMOD;
                const size_t off = (size_t)row * D + col0;
#pragma unroll
                for (int n = 0; n < 2; ++n) {
                    f32x4 gt = g0[n]; if (!uni) gt = *(const f32x4*)(gv + col0 + n * 16);
                    const f32x4 a = acc[ai][0][m][n], b = acc[ai][1][m][n], x4 = bf4_f4(xi[ai][m][n]); f32x4 o;
#pragma unroll
                    for (int j = 0; j < 4; ++j) o[j] = x4[j] + gt[j] * a[j] * sigmoid_f(b[j]);
                    u32x2 w; w.x = cvt_pk_bf16(o[0], o[1]); w.y = cvt_pk_bf16(o[2], o[3]);
                    *(u32x2*)(xo + off + n * 16) = w;
                }
            }
    }
};
struct EpiF32 {
    static constexpr bool PERM = false, AFTER_DRAIN = false;
    bf16_t* C; int ldc;
    template <int MB>
    __device__ __forceinline__ void operator()(const f32x4 (&acc)[2][2][MB][2], const Unit& u, int wr, int wc, int fr, int fq) const {
        const int row0 = u.pm * 64 * MB + wr * 16 * MB + fr, col0 = u.pn * BM + wc * 32 + 4 * fq;
#pragma unroll
        for (int ai = 0; ai < 2; ++ai)
#pragma unroll
            for (int m = 0; m < MB; ++m) { bf16_t* rowp = C + (size_t)(row0 + ai * 32 * MB + m * 16) * ldc + col0;
#pragma unroll
                for (int bj = 0; bj < 2; ++bj)
#pragma unroll
                    for (int n = 0; n < 2; ++n) { const f32x4 v = acc[ai][bj][m][n]; u32x2 w; w.x = cvt_pk_bf16(v[0], v[1]); w.y = cvt_pk_bf16(v[2], v[3]); *(u32x2*)(rowp + bj * HALF + n * 16) = w; } }
    }
};
struct EpiBf16 {
    static constexpr bool PERM = true, AFTER_DRAIN = false;
    bf16_t* O; int ldc;
    template <int MB>
    __device__ __forceinline__ void operator()(const f32x4 (&acc)[2][2][4][2], const Unit& u, int wr, int wc, int fr, int fq) const {
        const int row0 = u.pm * BM + wr * 64 + fr, col0 = u.pn * BM + wc * 32 + 8 * fq;
#pragma unroll
        for (int ai = 0; ai < 2; ++ai)
#pragma unroll
            for (int m = 0; m < 4; ++m) { bf16_t* rowp = O + (size_t)(row0 + ai * HALF + m * 16) * ldc + col0;
#pragma unroll
                for (int bj = 0; bj < 2; ++bj) { const f32x4 v0 = acc[ai][bj][m][0], v1 = acc[ai][bj][m][1];
                    u32x4 w; w.x = cvt_pk_bf16(v0[0], v0[1]); w.y = cvt_pk_bf16(v0[2], v0[3]); w.z = cvt_pk_bf16(v1[0], v1[1]); w.w = cvt_pk_bf16(v1[2], v1[3]);
                    *(u32x4*)(rowp + bj * HALF) = w; } }
    }
};
struct EpiQ {
    static constexpr bool PERM = false, AFTER_DRAIN = false;
    bf16_t* Q; const float* rc; const float* rs;
    template <int MB>
    __device__ __forceinline__ void operator()(const f32x4 (&acc)[2][2][4][2], const Unit& u, int wr, int wc, int fr, int fq) const {
        const int row0 = u.pm * BM + wr * 64 + fr; const bool lat = u.pm >= 16;
#pragma unroll
        for (int bj = 0; bj < 2; ++bj) {
            const int gi = u.pn * 8 + bj * 4 + wc, sub = gi % 6; const bool pe = lat && (sub >= 4);
            const int colb = gi * 32 + 4 * fq;
#pragma unroll
            for (int ai = 0; ai < 2; ++ai)
#pragma unroll
                for (int m = 0; m < 4; ++m) {
                    const int row = row0 + ai * HALF + m * 16;
                    f32x4 x0 = acc[ai][bj][m][0] * QSCALE, x1 = acc[ai][bj][m][1] * QSCALE;
                    if (pe) {
                        const int t = (row - MCTX) & 1023; const int fo = t * 32 + (sub - 4) * 16 + 4 * fq;
                        const f32x4 c = *(const f32x4*)(rc + fo), s = *(const f32x4*)(rs + fo);
                        const f32x4 y0 = x0 * c - x1 * s, y1 = x1 * c + x0 * s; x0 = y0; x1 = y1;
                    }
                    bf16_t* p = Q + (size_t)row * NQ + colb;
                    u32x2 w0, w1; w0.x = cvt_pk_bf16(x0[0], x0[1]); w0.y = cvt_pk_bf16(x0[2], x0[3]); w1.x = cvt_pk_bf16(x1[0], x1[1]); w1.y = cvt_pk_bf16(x1[2], x1[3]);
                    *(u32x2*)p = w0; *(u32x2*)(p + 16) = w1;
                }
        }
    }
};

template <class Epi, class Sched, bool ALIGN_EPI = false, bool SP2 = false, int MB = 4>
__device__ __forceinline__ void gemm_phase(LAS unsigned char* lds, const Gemm g, const Sched& S, const Epi& E) {
    const int tid = threadIdx.x, wid = __builtin_amdgcn_readfirstlane(tid >> 6), lane = tid & 63, wr = wid >> 2, wc = wid & 3, fr = lane & 15, fq = lane >> 4;
    const int K = g.K, nt = K / BK;
    unsigned voffA[2], voffB[2];
#pragma unroll
    for (int i = 0; i < 2; ++i) { int R, C; stage_rc(tid * 16 + i * 8192, R, C); const int Rb = Epi::PERM ? ((R & ~31) + perm32(R & 31)) : R;
        voffA[i] = (unsigned)(R * K + C) * 2u; voffB[i] = (unsigned)(Rb * K + C) * 2u; }
    const size_t kstep = (size_t)(BK * 2);
    const size_t hstep = (size_t)HALF * K * 2;
    const size_t tstep = 2 * hstep;
    const size_t hstepA = (size_t)(32 * MB) * K * 2;
    const size_t tstepA = 2 * hstepA;
    const unsigned ldsw = (unsigned)wid * 1024u;
    const int aoff = lds_byte(wr * 16 * MB + fr, fq * 8), boff = lds_byte(wc * 32 + fr, fq * 8);
    const bool a2nd = (MB == 4) || (MB == 3 && wr == 0);
#define PG8_SA(b, h) (((b) * 2 + (h)) * HTB)
#define PG8_SB(b, h) ((4 + (b) * 2 + (h)) * HTB)
#define PG8_STAGE(bufoff, gbase, voff) do { _Pragma("unroll") for (int _i = 0; _i < 2; ++_i) \
        __builtin_amdgcn_global_load_lds((const unsigned*)((const char*)(gbase) + (voff)[_i]), (LAS unsigned*)(lds + (bufoff) + ldsw + _i * 8192), 16, 0, 0); } while (0)
#define PG8_STAGEA(bufoff, gbase, voff) do { \
        __builtin_amdgcn_global_load_lds((const unsigned*)((const char*)(gbase) + (voff)[0]), (LAS unsigned*)(lds + (bufoff) + ldsw), 16, 0, 0); \
        if (a2nd) __builtin_amdgcn_global_load_lds((const unsigned*)((const char*)(gbase) + (voff)[1]), (LAS unsigned*)(lds + (bufoff) + ldsw + 8192), 16, 0, 0); } while (0)
#define PG8_WAIT_VA(n4, n3) do { if (!a2nd) asm volatile("s_waitcnt vmcnt(" #n3 ")" ::: "memory"); else asm volatile("s_waitcnt vmcnt(" #n4 ")" ::: "memory"); } while (0)
#define PG8_LDA(dst, b, h) do { _Pragma("unroll") for (int m = 0; m < MB; ++m) _Pragma("unroll") for (int k = 0; k < 2; ++k) dst[m][k] = *(const LAS bf16x8*)(lds + PG8_SA(b, h) + aoff + m * 2048 + k * 1024); } while (0)
#define PG8_LDB(dst, b, h) do { _Pragma("unroll") for (int n = 0; n < 2; ++n) _Pragma("unroll") for (int k = 0; k < 2; ++k) dst[n][k] = *(const LAS bf16x8*)(lds + PG8_SB(b, h) + boff + n * 2048 + k * 1024); } while (0)
#define PG8_MMA(ai, bj, At, Bt) do { __builtin_amdgcn_s_setprio(1); _Pragma("unroll") for (int m = 0; m < MB; ++m) _Pragma("unroll") for (int n = 0; n < 2; ++n) _Pragma("unroll") for (int k = 0; k < 2; ++k) \
        acc[ai][bj][m][n] = __builtin_amdgcn_mfma_f32_16x16x32_bf16(Bt[n][k], At[m][k], acc[ai][bj][m][n], 0, 0, 0); __builtin_amdgcn_s_setprio(0); } while (0)
#define PG8_WAIT_V(n) asm volatile("s_waitcnt vmcnt(" #n ")" ::: "memory")
#define PG8_WAIT_L(n) asm volatile("s_waitcnt lgkmcnt(" #n ")" ::: "memory")
#define PG8_BAR __builtin_amdgcn_s_barrier()
#define PG8_SCHED __builtin_amdgcn_sched_barrier(0)
    Unit cur, nxt; int ui = 0;
    if (!S.next(0, cur)) return;
    f32x4 acc[2][2][MB][2];
#pragma unroll
    for (int a = 0; a < 2; ++a)
#pragma unroll
        for (int b = 0; b < 2; ++b)
#pragma unroll
            for (int m = 0; m < MB; ++m)
#pragma unroll
                for (int n = 0; n < 2; ++n) acc[a][b][m][n] = (f32x4){0.f, 0.f, 0.f, 0.f};
    bf16x8 At[MB][2], B0[2][2], B1[2][2];
    const char* cA = (const char*)g.A + (size_t)cur.pm * tstepA; const char* cB = (const char*)g.Bt + (size_t)cur.pn * tstep;
    S.a_ready(cur);
    if constexpr (SP2) {
        PG8_STAGE(PG8_SB(0, 0), cB, voffB); PG8_STAGE(PG8_SB(0, 1), cB + hstep, voffB); PG8_STAGEA(PG8_SA(0, 0), cA, voffA); PG8_STAGEA(PG8_SA(0, 1), cA + hstepA, voffA);
        if (wr == 1) PG8_BAR;
        PG8_WAIT_VA(2, 1); PG8_BAR;
        PG8_STAGE(PG8_SB(1, 0), cB + kstep, voffB); PG8_STAGEA(PG8_SA(1, 0), cA + kstep, voffA); PG8_STAGE(PG8_SB(1, 1), cB + hstep + kstep, voffB);
        PG8_WAIT_VA(6, 5); PG8_BAR;
    } else {
        PG8_STAGE(PG8_SB(0, 0), cB, voffB); PG8_STAGEA(PG8_SA(0, 0), cA, voffA); PG8_STAGE(PG8_SB(0, 1), cB + hstep, voffB); PG8_STAGEA(PG8_SA(0, 1), cA + hstepA, voffA);
        if (wr == 1) PG8_BAR;
        PG8_WAIT_V(4); PG8_BAR;
        PG8_STAGE(PG8_SB(1, 0), cB + kstep, voffB); PG8_STAGEA(PG8_SA(1, 0), cA + kstep, voffA); PG8_STAGE(PG8_SB(1, 1), cB + hstep + kstep, voffB);
        PG8_WAIT_V(6); PG8_BAR;
    }
    for (;;) {
        const bool has_next = S.next(ui + 1, nxt);
        const char* nA = has_next ? (const char*)g.A + (size_t)nxt.pm * tstepA : cA; const char* nB = has_next ? (const char*)g.Bt + (size_t)nxt.pn * tstep : cB;
        for (int t = 0; t < nt; t += 2) {
            const bool last = (t == nt - 2);
            const char* a1 = cA + (size_t)(t + 1) * kstep;
            const char* a2 = last ? nA : cA + (size_t)(t + 2) * kstep; const char* b2 = last ? nB : cB + (size_t)(t + 2) * kstep;
            const char* a3 = a2 + kstep; const char* b3 = b2 + kstep;
            if (last && has_next) S.a_ready(nxt);
            if constexpr (SP2) {
            PG8_LDB(B0, 0, 0); PG8_LDB(B1, 0, 1); PG8_SCHED; PG8_LDA(At, 0, 0); PG8_STAGEA(PG8_SA(1, 1), a1 + hstepA, voffA);
            PG8_WAIT_VA(8, 6); PG8_WAIT_L(0); PG8_BAR; PG8_MMA(0, 0, At, B0); PG8_MMA(0, 1, At, B1); PG8_BAR; PG8_SCHED;
            PG8_LDA(At, 0, 1); PG8_STAGE(PG8_SB(0, 0), b2, voffB); PG8_STAGE(PG8_SB(0, 1), b2 + hstep, voffB); PG8_STAGEA(PG8_SA(0, 0), a2, voffA);
            PG8_WAIT_VA(8, 6); PG8_WAIT_L(0); PG8_BAR; PG8_MMA(1, 0, At, B0); PG8_MMA(1, 1, At, B1); PG8_BAR; PG8_SCHED;
            PG8_LDB(B0, 1, 0); PG8_LDB(B1, 1, 1); PG8_SCHED; PG8_LDA(At, 1, 0); PG8_STAGEA(PG8_SA(0, 1), a2 + hstepA, voffA);
            PG8_WAIT_VA(8, 6); PG8_WAIT_L(0); PG8_BAR; PG8_MMA(0, 0, At, B0); PG8_MMA(0, 1, At, B1); PG8_BAR; PG8_SCHED;
            PG8_LDA(At, 1, 1); PG8_STAGE(PG8_SB(1, 0), b3, voffB); PG8_STAGE(PG8_SB(1, 1), b3 + hstep, voffB); PG8_STAGEA(PG8_SA(1, 0), a3, voffA);
            PG8_WAIT_VA(8, 6); PG8_WAIT_L(0); PG8_BAR; PG8_MMA(1, 0, At, B0); PG8_MMA(1, 1, At, B1); PG8_BAR; PG8_SCHED;
            } else {
            PG8_LDB(B0, 0, 0); PG8_SCHED; PG8_LDA(At, 0, 0); PG8_STAGEA(PG8_SA(1, 1), a1 + hstepA, voffA);
            PG8_WAIT_L(8); PG8_BAR; PG8_WAIT_L(0); PG8_MMA(0, 0, At, B0); PG8_BAR; PG8_SCHED;
            PG8_LDB(B1, 0, 1); PG8_STAGE(PG8_SB(0, 0), b2, voffB);
            PG8_BAR; PG8_WAIT_L(0); PG8_MMA(0, 1, At, B1); PG8_BAR;
            PG8_LDA(At, 0, 1); PG8_STAGEA(PG8_SA(0, 0), a2, voffA);
            PG8_BAR; PG8_WAIT_L(0); PG8_MMA(1, 0, At, B0); PG8_BAR; PG8_SCHED;
            PG8_STAGE(PG8_SB(0, 1), b2 + hstep, voffB);
            PG8_WAIT_V(6); PG8_BAR; PG8_MMA(1, 1, At, B1); PG8_BAR;
            PG8_LDB(B0, 1, 0); PG8_SCHED; PG8_LDA(At, 1, 0); PG8_STAGEA(PG8_SA(0, 1), a2 + hstepA, voffA);
            PG8_WAIT_L(8); PG8_BAR; PG8_WAIT_L(0); PG8_MMA(0, 0, At, B0); PG8_BAR; PG8_SCHED;
            PG8_LDB(B1, 1, 1); PG8_STAGE(PG8_SB(1, 0), b3, voffB);
            PG8_BAR; PG8_WAIT_L(0); PG8_MMA(0, 1, At, B1); PG8_BAR;
            PG8_LDA(At, 1, 1); PG8_STAGEA(PG8_SA(1, 0), a3, voffA);
            PG8_BAR; PG8_WAIT_L(0); PG8_MMA(1, 0, At, B0); PG8_BAR; PG8_SCHED;
            PG8_STAGE(PG8_SB(1, 1), b3 + hstep, voffB);
            PG8_WAIT_V(6); PG8_BAR; PG8_MMA(1, 1, At, B1); PG8_BAR;
            }
        }
        if constexpr (ALIGN_EPI) { if (wr == 0) PG8_BAR; }
        if constexpr (!Epi::AFTER_DRAIN) { E.template operator()<MB>(acc, cur, wr, wc, fr, fq); S.done(cur); }
        if (!has_next) break;
#pragma unroll
        for (int a = 0; a < 2; ++a)
#pragma unroll
            for (int b = 0; b < 2; ++b)
#pragma unroll
                for (int m = 0; m < MB; ++m)
#pragma unroll
                    for (int n = 0; n < 2; ++n) acc[a][b][m][n] = (f32x4){0.f, 0.f, 0.f, 0.f};
        cur = nxt; cA = nA; cB = nB; ++ui;
        if constexpr (ALIGN_EPI) { if (wr == 1) PG8_BAR; }
    }
    PG8_WAIT_V(0);
    if constexpr (!ALIGN_EPI) { if (wr == 0) PG8_BAR; }
    PG8_BAR;
#undef PG8_SA
#undef PG8_SB
#undef PG8_STAGE
#undef PG8_STAGEA
#undef PG8_WAIT_VA
#undef PG8_LDA
#undef PG8_LDB
#undef PG8_MMA
#undef PG8_WAIT_V
#undef PG8_WAIT_L
#undef PG8_BAR
#undef PG8_SCHED
}
}

#define XB_TMO      128
#define XB_XCNT(j)  (256  + 64 * (j))
#define XB_XSUB(j)  (1280 + 64 * (j))
#define XB_XGEN(j)  (2304 + 64 * (j))
#define XB_TOP      3328
#define XB_TOPGEN   3392
#define XCD_BAR_WORDS 3456
#define XB_SPIN_CAP (1u << 18)
__device__ __forceinline__ unsigned xb_ld(unsigned* p)              { return __hip_atomic_load(p, __ATOMIC_RELAXED, __HIP_MEMORY_SCOPE_AGENT); }
__device__ __forceinline__ unsigned xb_add(unsigned* p, unsigned v) { return __hip_atomic_fetch_add(p, v, __ATOMIC_RELAXED, __HIP_MEMORY_SCOPE_AGENT); }
__device__ __forceinline__ unsigned xb_xcc_id() { return (unsigned)__builtin_amdgcn_s_getreg((3 << 11) | 20) & 0xFu; }
#define XB_SPIN(cond, bar) do { unsigned _sp = 0; while (cond) { __builtin_amdgcn_s_sleep(1); \
    if ((++_sp & 255u) == 0u) { if (xb_ld(&(bar)[XB_TMO])) break; if (_sp > XB_SPIN_CAP) { atomicAdd(&(bar)[XB_TMO], 1u); break; } } } } while (0)
struct XcdBarrier { unsigned* bar; unsigned x; volatile LAS unsigned* st; };
__device__ __forceinline__ XcdBarrier xcd_barrier_post(unsigned* bar, volatile LAS unsigned* st) {
    XcdBarrier b; b.bar = bar; b.x = xb_xcc_id(); b.st = st;
    if (threadIdx.x == 0) (void)xb_add(&bar[XB_XCNT(b.x)], 1u);
    return b;
}
__device__ __forceinline__ void xcd_barrier_complete(unsigned* bar, unsigned x, unsigned& nloc, unsigned& nx) {
    const unsigned G = gridDim.x * gridDim.y * gridDim.z;
    unsigned sum, cnt, mine, sp = 0u;
    for (;;) {
        sum = 0u; cnt = 0u; mine = 0u;
#pragma unroll
        for (unsigned j = 0; j < 16; ++j) { const unsigned c = xb_ld(&bar[XB_XCNT(j)]); sum += c; cnt += (c > 0u) ? 1u : 0u; mine = (j == x) ? c : mine; }
        if (sum == G) break;
        __builtin_amdgcn_s_sleep(1);
        if ((++sp & 255u) == 0u) { if (xb_ld(&bar[XB_TMO])) break; if (sp > XB_SPIN_CAP) { atomicAdd(&bar[XB_TMO], 1u); break; } }
    }
    nloc = mine > 0u ? mine : 1u; nx = cnt > 0u ? cnt : 1u;
}
__device__ __forceinline__ void xcd_barrier(const XcdBarrier& b) {
    asm volatile("s_waitcnt vmcnt(0)" ::: "memory");
    __syncthreads();
    if (threadIdx.x == 0) {
        unsigned* bar = b.bar;
        __builtin_amdgcn_s_waitcnt(0);
        unsigned nloc = b.st[0], nx = b.st[1];
        if (nloc == 0u) { xcd_barrier_complete(bar, b.x, nloc, nx); b.st[0] = nloc; b.st[1] = nx; }
        const unsigned old = xb_add(&bar[XB_XSUB(b.x)], 1u);
        const unsigned gen = old / nloc;
        if (old + 1u == (gen + 1u) * nloc) {
            __builtin_amdgcn_fence(__ATOMIC_RELEASE, "agent");
            asm volatile("s_waitcnt vmcnt(0)" ::: "memory");
            const unsigned og = xb_add(&bar[XB_TOP], 1u);
            const unsigned tg = og / nx;
            if (og + 1u == (tg + 1u) * nx) xb_add(&bar[XB_TOPGEN], 1u);
            else XB_SPIN(xb_ld(&bar[XB_TOPGEN]) == tg, bar);
            __builtin_amdgcn_fence(__ATOMIC_ACQUIRE, "agent");
            xb_add(&bar[XB_XGEN(b.x)], 1u);
            asm volatile("s_waitcnt vmcnt(0)" ::: "memory");
        } else {
            XB_SPIN(xb_ld(&bar[XB_XGEN(b.x)]) == gen, bar);
            __builtin_amdgcn_fence(__ATOMIC_ACQUIRE, "agent");
            asm volatile("s_waitcnt vmcnt(0)" ::: "memory");
        }
    }
    __syncthreads();
}

struct Args { const float* in[30]; float* out; unsigned char* ws; int ph_lo, ph_hi, use_bar, pad; };
struct Frame {
    LAS unsigned char* lds;
    int tid, lane, wave, vcu, G;
};
typedef const __attribute__((address_space(4))) Args* KA;
__device__ __forceinline__ KA get_ka() { KA p = (KA)__builtin_amdgcn_kernarg_segment_ptr(); asm volatile("" : "+s"(p)); return p; }
#define IN_(i) (ka->in[i])
#define WS_ (ka->ws)
#define OUT_ (ka->out)
#define MODS_ ((float*)(ka->ws + WS_MODS))
#define ROPEC_ ((float*)(ka->ws + WS_ROPE))
#define ROPES_ ((float*)(ka->ws + WS_ROPE) + 1024 * 32)
enum { I_XP = 0, I_XS, I_CCKV, I_CKPE, I_SRE, I_SIM, I_C, I_CCTX, I_MODW, I_MODB, I_NORMG, I_WIN, I_WOUT, I_WDQ, I_QNORM, I_WUQ, I_WDKV, I_KVNORM, I_WUKV, I_WO,
       I_ARE, I_AIM, I_LOGDT, I_BRE, I_BIM, I_CRE, I_CIM, I_S5D, I_WGLU, I_FING };

__device__ __forceinline__ void tr_item(const float* W, int K, int N, bf16_t* WT, int k0, int n0, LAS float* scr, int lane) {
    const int lr = lane >> 4, lc = lane & 15;
    f32x4 v[16];
#pragma unroll
    for (int i = 0; i < 16; ++i) v[i] = __builtin_nontemporal_load((const f32x4*)(W + (size_t)(k0 + 4 * i + lr) * N + n0 + 4 * lc));
#pragma unroll
    for (int i = 0; i < 16; ++i) { const int k = 4 * i + lr; *(LAS f32x4*)(scr + k * 64 + ((4 * lc) ^ (4 * ((k >> 3) & 7)))) = v[i]; }
    asm volatile("s_waitcnt lgkmcnt(0)" ::: "memory");
    const int c = lane & 7;
#pragma unroll
    for (int j = 0; j < 8; ++j) {
        const int n = (lane >> 3) + 8 * j; const LAS float* s = scr + (8 * c) * 64 + (n ^ (4 * c));
        u32x4 o; o.x = cvt_pk_bf16(s[0 * 64], s[1 * 64]); o.y = cvt_pk_bf16(s[2 * 64], s[3 * 64]); o.z = cvt_pk_bf16(s[4 * 64], s[5 * 64]); o.w = cvt_pk_bf16(s[6 * 64], s[7 * 64]);
        *(u32x4*)(WT + (size_t)n * K + k0 + 8 * c) = o;
    }
    asm volatile("s_waitcnt lgkmcnt(0)" ::: "memory");
}
__device__ __forceinline__ int ilv_row(int n, int Hh) { const int hi = n >= Hh ? 1 : 0; const int c = n - hi * Hh; return 256 * (c >> 7) + 128 * hi + (c & 127); }

__device__ __forceinline__ int conv_items(int m) {
    return m < 4 ? 32 * 176 : m < 8 ? 88 * 32 : m == 8 ? 32 * 12 : m == 9 ? 32 * 9 : m == 10 ? 12 * 48 : m == 11 ? 8 * 64 : m == 12 ? 32 * 32 : 32 * 64;
}
__device__ __forceinline__ void conv_item(KA ka, int m, int r, LAS float* scr, int lane) {
    if (m < 4) { const int kb = r / 176, nb = r % 176;
        tr_item(IN_(I_WIN) + (size_t)m * D * NFF2, D, NFF2, (bf16_t*)(WS_ + WS_WIN) + (size_t)m * NFF2 * D + (size_t)ilv_row(64 * nb, DFF) * D, 64 * kb, 64 * nb, scr, lane); }
    else if (m < 8) { const int mi = m - 4, kb = r / 32, nb = r % 32;
        tr_item(IN_(I_WOUT) + (size_t)mi * DFF * D, DFF, D, (bf16_t*)(WS_ + WS_WOUT) + (size_t)mi * D * DFF + (size_t)(64 * nb) * DFF, 64 * kb, 64 * nb, scr, lane); }
    else if (m == 8) { const int kb = r / 12, nb = r % 12;
        tr_item(IN_(I_WDQ), D, QL, (bf16_t*)(WS_ + WS_WA) + (size_t)(64 * nb) * D, 64 * kb, 64 * nb, scr, lane); }
    else if (m == 9) { const int kb = r / 9, nb = r % 9;
        tr_item(IN_(I_WDKV), D, 576, (bf16_t*)(WS_ + WS_WA) + (size_t)(QL + 64 * nb) * D, 64 * kb, 64 * nb, scr, lane); }
    else if (m == 10) { const int kb = r / 48, nb = r % 48;
        tr_item(IN_(I_WUQ), QL, NQ, (bf16_t*)(WS_ + WS_WUQ) + (size_t)(64 * nb) * QL, 64 * kb, 64 * nb, scr, lane); }
    else if (m == 11) { const int kb = r / 64, nb = r % 64; const int n0 = 64 * nb, hh = n0 >> 8, j = n0 & 255; const int drow = (j < 128 ? 0 : 2048) + hh * 128 + (j & 127);
        tr_item(IN_(I_WUKV), KVL, 4096, (bf16_t*)(WS_ + WS_WUK) + (size_t)drow * KVL, 64 * kb, n0, scr, lane); }
    else if (m == 12) { const int kb = r / 32, nb = r % 32;
        tr_item(IN_(I_WO), D, D, (bf16_t*)(WS_ + WS_WO) + (size_t)(64 * nb) * D, 64 * kb, 64 * nb, scr, lane); }
    else { const int kb = r / 64, nb = r % 64;
        tr_item(IN_(I_WGLU), D, 4096, (bf16_t*)(WS_ + WS_WGLU) + (size_t)ilv_row(64 * nb, D) * D, 64 * kb, 64 * nb, scr, lane); }
}
constexpr int WIN1_SPLIT = 1792;
__device__ __forceinline__ unsigned conv_slot_mask(int slot) {
    return slot == 0 ? (1u << 0)
         : slot == 1 ? ((1u << 4) | (1u << 8) | (1u << 9) | (1u << 10) | (1u << 11) | (1u << 12) | (1u << 1))
         : slot == 2 ? (1u << 1)
         : slot == 3 ? ((1u << 5) | (1u << 2))
         : slot == 6 ? (1u << 13)
         : slot == 4 ? ((1u << 6) | (1u << 3))
         : (1u << 7);
}
__device__ __forceinline__ void convert_slot(Frame& F, KA ka, int slot, int worker, int nworkers) {
    LAS float* scr = (LAS float*)(F.lds + F.wave * 16384);
    const unsigned mask = conv_slot_mask(slot);
    int base = 0;
#pragma unroll 1
    for (int m = 0; m < 14; ++m) {
        if (!((mask >> m) & 1u)) continue;
        int lo = 0, hi = conv_items(m);
        if (m == 1) { if (slot == 1) hi = WIN1_SPLIT; else lo = WIN1_SPLIT; }
        const int n = hi - lo;
        int it = worker - (base % nworkers); if (it < 0) it += nworkers;
        for (; it < n; it += nworkers) conv_item(ka, m, lo + it, scr, F.lane);
        base += n;
    }
}
__device__ __forceinline__ void phase_prologue(Frame& F) {
    KA ka = get_ka();
    const int tid = F.tid;
    for (int i = blockIdx.x * 512 + tid; i < 1024 * 32; i += F.G * 512) {
        const int t = i >> 5, f = i & 31; const int pos = (f < 16) ? (t >> 6) : (t & 63);
        const float inv = exp2f(-(float)(f & 15) * (13.287712379549449f / 16.0f));
        const float ang = (float)pos * inv;
        ROPEC_[i] = cosf(ang); ROPES_[i] = sinf(ang);
    }
    {
        bf16_t* ckv = (bf16_t*)(WS_ + WS_CKV); bf16_t* kpe = (bf16_t*)(WS_ + WS_KPE);
        for (int i = blockIdx.x * 512 + tid; i < 2 * 256 * 128; i += F.G * 512) {
            const int row = i >> 7, c4 = i & 127, b = row >> 8, s = row & 255;
            const f32x4 v = *(const f32x4*)(IN_(I_CCKV) + (size_t)row * 512 + 4 * c4);
            u32x2 w; w.x = cvt_pk_bf16(v[0], v[1]); w.y = cvt_pk_bf16(v[2], v[3]);
            *(u32x2*)(ckv + (size_t)(MCTX + b * 1280 + s) * 512 + 4 * c4) = w;
        }
        for (int i = blockIdx.x * 512 + tid; i < 2 * 256 * 16; i += F.G * 512) {
            const int row = i >> 4, c4 = i & 15, b = row >> 8, s = row & 255;
            const f32x4 v = *(const f32x4*)(IN_(I_CKPE) + (size_t)row * 64 + 4 * c4);
            u32x2 w; w.x = cvt_pk_bf16(v[0], v[1]); w.y = cvt_pk_bf16(v[2], v[3]);
            *(u32x2*)(kpe + (size_t)(MCTX + b * 1280 + s) * 64 + 4 * c4) = w;
        }
    }
    {
        LAS float* sc = (LAS float*)F.lds;
        LAS float* red = sc + 3 * 2048;
        for (int i = tid; i < 3 * 2048; i += 512) { const int s = i >> 11, k = i & 2047; const float v = (s == 0) ? IN_(I_CCTX)[k] : IN_(I_C)[(s - 1) * 2048 + k]; sc[i] = v / (1.0f + expf(-v)); }
        __syncthreads();
        const int c4 = tid & 31, kg = tid >> 5;
        for (int tile = blockIdx.x; tile < 288; tile += F.G) {
            const int l = tile / 144, n0 = (tile % 144) * 128;
            const float* wp = IN_(I_MODW) + ((size_t)l * 2048 + kg * 128) * NMOD + n0 + 4 * c4;
            f32x4 a0 = {0.f, 0.f, 0.f, 0.f}, a1 = a0, a2 = a0;
#pragma unroll 8
            for (int j = 0; j < 128; ++j) {
                const f32x4 w = __builtin_nontemporal_load((const f32x4*)(wp + (size_t)j * NMOD));
                const int k = kg * 128 + j; a0 += w * sc[k]; a1 += w * sc[2048 + k]; a2 += w * sc[4096 + k];
            }
#pragma unroll
            for (int i = 0; i < 4; ++i) { red[(kg * 3 + 0) * 128 + 4 * c4 + i] = a0[i]; red[(kg * 3 + 1) * 128 + 4 * c4 + i] = a1[i]; red[(kg * 3 + 2) * 128 + 4 * c4 + i] = a2[i]; }
            __syncthreads();
            if (tid < 384) {
                const int s = tid >> 7, n = tid & 127; float sum = 0.f;
#pragma unroll 8
                for (int g = 0; g < 16; ++g) sum += red[(g * 3 + s) * 128 + n];
                MODS_[(size_t)(l * 3 + s) * NMOD + n0 + n] = sum + IN_(I_MODB)[l * NMOD + n0 + n];
            }
            __syncthreads();
        }
    }
    __syncthreads();
    {
        LAS float* scr = (LAS float*)(F.lds + F.wave * 16384);
        if ((int)blockIdx.x >= 32) { const int nb2 = F.G - 32; for (int it = ((int)blockIdx.x - 32) * 8 + F.wave; it < 5632; it += nb2 * 8) conv_item(ka, 0, it, scr, F.lane); }
    }
}

__device__ __forceinline__ void phase_norm(Frame& F, int l, int sub, bool first_sub) {
    KA ka = get_ka();
    const float* xa = IN_(I_XP); const float* xb = IN_(I_XS) - (size_t)MCTX * D; const bf16_t* X = (const bf16_t*)(WS_ + WS_X);
    const int gw = F.vcu * 8 + F.wave, NGW = F.G * 8, lane = F.lane;
    bf16_t* H = (bf16_t*)(WS_ + WS_H);
    const float* gp = IN_(I_NORMG) + (size_t)(l * 3 + sub) * D;
    for (int chunk = gw; chunk < MT / 3; chunk += NGW) {
        f32x4 vf[3][8]; u32x2 vh[3][8];
#pragma unroll
        for (int r = 0; r < 3; ++r) {
            const int row = 3 * chunk + r; const float* xr = (row < MCTX ? xa : xb) + (size_t)row * D;
#pragma unroll
            for (int j = 0; j < 8; ++j) { if (first_sub) vf[r][j] = *(const f32x4*)(xr + 4 * lane + 256 * j); else vh[r][j] = *(const u32x2*)(X + (size_t)row * D + 4 * lane + 256 * j); }
        }
        int ms_have = -1; f32x4 gs[8], sh[8];
#pragma unroll
        for (int r = 0; r < 3; ++r) {
            const int row = 3 * chunk + r;
            const int ms = row < MCTX ? 0 : 1 + ((row - MCTX) >> 10);
            if (ms != ms_have) {
                const float* mv = MODS_ + (size_t)(l * 3 + ms) * NMOD + sub * 3 * D;
#pragma unroll
                for (int j = 0; j < 8; ++j) { const int idx = 4 * lane + 256 * j; gs[j] = *(const f32x4*)(gp + idx) * (*(const f32x4*)(mv + D + idx) + 1.0f); sh[j] = *(const f32x4*)(mv + idx); }
                ms_have = ms;
            }
            f32x4 v[8]; float ss = 0.f;
#pragma unroll
            for (int j = 0; j < 8; ++j) { v[j] = first_sub ? vf[r][j] : pg8::bf4_f4(vh[r][j]); ss += (v[j][0] * v[j][0] + v[j][1] * v[j][1]) + (v[j][2] * v[j][2] + v[j][3] * v[j][3]); }
            ss = wave_sum(ss);
            const float rstd = 1.0f / sqrtf(ss * (1.0f / D) + EPS);
#pragma unroll
            for (int j = 0; j < 8; ++j) {
                const f32x4 o = v[j] * rstd * gs[j] + sh[j];
                u32x2 w; w.x = cvt_pk_bf16(o[0], o[1]); w.y = cvt_pk_bf16(o[2], o[3]);
                *(u32x2*)(H + (size_t)row * D + 4 * lane + 256 * j) = w;
            }
        }
    }
}
__device__ __forceinline__ void phase_final(Frame& F) {
    KA ka = get_ka();
    const int gw = F.vcu * 8 + F.wave, NGW = F.G * 8, lane = F.lane;
    const bf16_t* X = (const bf16_t*)(WS_ + WS_X); const float* gp = IN_(I_FING);
    f32x4 gq[8];
#pragma unroll
    for (int j = 0; j < 8; ++j) gq[j] = *(const f32x4*)(gp + 4 * lane + 256 * j);
    for (int row0 = gw; row0 < MT; row0 += 3 * NGW) {
        u32x2 vh[3][8];
#pragma unroll
        for (int r = 0; r < 3; ++r) { const int row = row0 + r * NGW; const bf16_t* xr = X + (size_t)(row < MT ? row : row0) * D;
#pragma unroll
            for (int j = 0; j < 8; ++j) vh[r][j] = *(const u32x2*)(xr + 4 * lane + 256 * j); }
#pragma unroll
        for (int r = 0; r < 3; ++r) {
            const int row = row0 + r * NGW; if (row >= MT) break;
            f32x4 v[8]; float ss = 0.f;
#pragma unroll
            for (int j = 0; j < 8; ++j) { v[j] = pg8::bf4_f4(vh[r][j]); ss += (v[j][0] * v[j][0] + v[j][1] * v[j][1]) + (v[j][2] * v[j][2] + v[j][3] * v[j][3]); }
            ss = wave_sum(ss);
            const float rstd = 1.0f / sqrtf(ss * (1.0f / D) + EPS);
#pragma unroll
            for (int j = 0; j < 8; ++j) { const int idx = 4 * lane + 256 * j; __builtin_nontemporal_store(v[j] * rstd * gq[j], (f32x4*)(OUT_ + OUT_Y + (size_t)row * D + idx)); }
        }
    }
}
__device__ __forceinline__ void phase_mla_norm(Frame& F) {
    KA ka = get_ka();
    const int gw = F.vcu * 8 + F.wave, NGW = F.G * 8, lane = F.lane;
    const bf16_t* C = (const bf16_t*)(WS_ + WS_CQKV);
    bf16_t* CQ = (bf16_t*)(WS_ + WS_CQ); bf16_t* CKV = (bf16_t*)(WS_ + WS_CKV); bf16_t* KPE = (bf16_t*)(WS_ + WS_KPE);
    const float* qn = IN_(I_QNORM); const float* kn = IN_(I_KVNORM);
    f32x4 qg[3], kg[2];
#pragma unroll
    for (int j = 0; j < 3; ++j) qg[j] = *(const f32x4*)(qn + 4 * lane + 256 * j);
#pragma unroll
    for (int j = 0; j < 2; ++j) kg[j] = *(const f32x4*)(kn + 4 * lane + 256 * j);
    for (int row = gw; row < MT; row += NGW) {
        const bf16_t* cr = C + (size_t)row * NA;
        const bool lat = row >= MCTX; const int lb = (row - MCTX) >> 10, t = (row - MCTX) & 1023;
        const int drow = lat ? (MCTX + lb * 1280 + 256 + t) : row;
        f32x4 a[3]; float ss = 0.f;
#pragma unroll
        for (int j = 0; j < 3; ++j) { a[j] = pg8::bf4_f4(*(const u32x2*)(cr + 4 * lane + 256 * j)); ss += (a[j][0] * a[j][0] + a[j][1] * a[j][1]) + (a[j][2] * a[j][2] + a[j][3] * a[j][3]); }
        ss = wave_sum(ss);
        float rstd = 1.0f / sqrtf(ss * (1.0f / QL) + EPS);
#pragma unroll
        for (int j = 0; j < 3; ++j) { const int idx = 4 * lane + 256 * j; const f32x4 o = a[j] * rstd * qg[j];
            u32x2 w; w.x = cvt_pk_bf16(o[0], o[1]); w.y = cvt_pk_bf16(o[2], o[3]); *(u32x2*)(CQ + (size_t)row * QL + idx) = w; }
        f32x4 b[2]; ss = 0.f;
#pragma unroll
        for (int j = 0; j < 2; ++j) { b[j] = pg8::bf4_f4(*(const u32x2*)(cr + QL + 4 * lane + 256 * j)); ss += (b[j][0] * b[j][0] + b[j][1] * b[j][1]) + (b[j][2] * b[j][2] + b[j][3] * b[j][3]); }
        ss = wave_sum(ss);
        rstd = 1.0f / sqrtf(ss * (1.0f / KVL) + EPS);
#pragma unroll
        for (int j = 0; j < 2; ++j) { const int idx = 4 * lane + 256 * j; const f32x4 o = b[j] * rstd * kg[j];
            u32x2 w; w.x = cvt_pk_bf16(o[0], o[1]); w.y = cvt_pk_bf16(o[2], o[3]); *(u32x2*)(CKV + (size_t)drow * KVL + idx) = w;
            if (!lat) *(f32x4*)(OUT_ + OUT_CKV + (size_t)row * KVL + idx) = o; }
        float kv = __uint_as_float((unsigned)(*(const unsigned short*)(cr + QL + KVL + lane)) << 16);
        if (!lat) OUT_[OUT_KPE + (size_t)row * 64 + lane] = kv;
        const float partner = __shfl_xor(kv, 16);
        if (lat) {
            const int f = (lane & 15) + 16 * (lane >> 5);
            const float c = ROPEC_[t * 32 + f], s = ROPES_[t * 32 + f];
            const float rot = (lane & 16) ? partner : -partner;
            kv = kv * c + rot * s;
        }
        const float nb = __shfl_down(kv, 1);
        if ((lane & 1) == 0) *(unsigned*)(KPE + (size_t)drow * 64 + lane) = cvt_pk_bf16(kv, nb);
    }
}

constexpr int AT_KROW = 416, AT_VROW = 160, AT_KT = 64 * AT_KROW, AT_VT = 128 * AT_VROW, AT_STAGE = AT_KT + AT_VT;
__device__ __forceinline__ float xg_max(float v) {
    auto a = __builtin_amdgcn_permlane16_swap(__float_as_uint(v), __float_as_uint(v), false, false);
    v = fmaxf(__uint_as_float(a[0]), __uint_as_float(a[1]));
    auto b = __builtin_amdgcn_permlane32_swap(__float_as_uint(v), __float_as_uint(v), false, false);
    return fmaxf(__uint_as_float(b[0]), __uint_as_float(b[1]));
}
__device__ __forceinline__ float xg_sum(float v) {
    auto a = __builtin_amdgcn_permlane16_swap(__float_as_uint(v), __float_as_uint(v), false, false);
    v = __uint_as_float(a[0]) + __uint_as_float(a[1]);
    auto b = __builtin_amdgcn_permlane32_swap(__float_as_uint(v), __float_as_uint(v), false, false);
    return __uint_as_float(b[0]) + __uint_as_float(b[1]);
}
__device__ __forceinline__ void phase_attn(Frame& F) {
    KA ka = get_ka();
    const int tid = F.tid, lane = F.lane, wave = F.wave, l15 = lane & 15, g4 = lane >> 4;
    const bf16_t* Q = (const bf16_t*)(WS_ + WS_Q); const bf16_t* KN = (const bf16_t*)(WS_ + WS_KN); const bf16_t* KPE = (const bf16_t*)(WS_ + WS_KPE);
    const bf16_t* VT = (const bf16_t*)(WS_ + WS_VT); bf16_t* O = (bf16_t*)(WS_ + WS_O);
    LAS unsigned char* lds = F.lds;
    for (int unit = F.vcu; unit < 768; unit += F.G) {
        int b, h, qb, qrow0, krow0, nk;
        if (unit < 256) { b = unit >> 7; h = (unit >> 3) & 15; qb = unit & 7; qrow0 = MCTX + b * 1024 + qb * 128; krow0 = MCTX + b * 1280; nk = 1280; }
        else { const int u2 = unit - 256; b = u2 >> 5; h = (u2 >> 1) & 15; qb = u2 & 1; qrow0 = b * 256 + qb * 128; krow0 = b * 256; nk = 256; }
        const int ntile = nk >> 6;
        bf16x8 qf[6];
        { const bf16_t* qp = Q + (size_t)(qrow0 + wave * 16 + l15) * NQ + h * 192 + 8 * g4;
#pragma unroll
          for (int s = 0; s < 6; ++s) qf[s] = *(const bf16x8*)(qp + 32 * s); }
        const bf16_t* ksrc[3]; int kdst[3]; int kstr[3];
#pragma unroll
        for (int i = 0; i < 3; ++i) { const int idx = tid + 512 * i, row = idx / 24, ch = idx % 24;
            const int key = 32 * (row >> 5) + 8 * ((row >> 2) & 3) + 4 * ((row >> 4) & 1) + (row & 3);
            ksrc[i] = (ch < 16) ? KN + (size_t)(krow0 + key) * D + h * 128 + ch * 8 : KPE + (size_t)(krow0 + key) * 64 + (ch - 16) * 8;
            kstr[i] = (ch < 16) ? 64 * D : 64 * 64;
            kdst[i] = row * AT_KROW + ch * 16; }
        const bf16_t* vsrc[2]; int vdst[2];
#pragma unroll
        for (int i = 0; i < 2; ++i) { const int idx = tid + 512 * i, row = idx >> 3, ch = idx & 7;
            vsrc[i] = VT + (size_t)(h * 128 + row) * KVR + krow0 + ch * 8; vdst[i] = AT_KT + row * AT_VROW + ch * 16; }
        u32x4 ka_[3], va_[2], kb_[3], vb_[2];
#define AT_LOAD(KS, VS, t) do { _Pragma("unroll") for (int i = 0; i < 3; ++i) KS[i] = *(const u32x4*)(ksrc[i] + (size_t)(t) * kstr[i]); \
                                _Pragma("unroll") for (int i = 0; i < 2; ++i) VS[i] = *(const u32x4*)(vsrc[i] + (t) * 64); } while (0)
#define AT_STORE(KS, VS, off) do { _Pragma("unroll") for (int i = 0; i < 3; ++i) *(LAS u32x4*)(lds + (off) + kdst[i]) = KS[i]; \
                                   _Pragma("unroll") for (int i = 0; i < 2; ++i) *(LAS u32x4*)(lds + (off) + vdst[i]) = VS[i]; } while (0)
        AT_LOAD(kb_, vb_, 0);
        AT_LOAD(ka_, va_, 1);
        __syncthreads();
        AT_STORE(kb_, vb_, 0);
        __syncthreads();
        f32x4 o[8];
#pragma unroll
        for (int i = 0; i < 8; ++i) o[i] = (f32x4){0.f, 0.f, 0.f, 0.f};
        float m_run = -INFINITY, l_run = 0.f;
#define AT_STEP(cur) do { \
            f32x4 sc[4]; \
            _Pragma("unroll") for (int kb = 0; kb < 4; ++kb) { \
                f32x4 a = {0.f, 0.f, 0.f, 0.f}; \
                const LAS unsigned char* kp = lds + (cur) + (16 * kb + l15) * AT_KROW + g4 * 16; \
                _Pragma("unroll") for (int s = 0; s < 6; ++s) { const bf16x8 kf = *(const LAS bf16x8*)(kp + s * 64); a = __builtin_amdgcn_mfma_f32_16x16x32_bf16(kf, qf[s], a, 0, 0, 0); } \
                sc[kb] = a; } \
            float mx = fmaxf(fmaxf(sc[0][0], sc[0][1]), fmaxf(sc[0][2], sc[0][3])); \
            _Pragma("unroll") for (int kb = 1; kb < 4; ++kb) mx = fmaxf(mx, fmaxf(fmaxf(sc[kb][0], sc[kb][1]), fmaxf(sc[kb][2], sc[kb][3]))); \
            mx = xg_max(mx); \
            const float m_new = fmaxf(m_run, mx); \
            const float alpha = __builtin_amdgcn_exp2f(m_run - m_new); \
            m_run = m_new; \
            float ps = 0.f; \
            _Pragma("unroll") for (int kb = 0; kb < 4; ++kb) _Pragma("unroll") for (int i = 0; i < 4; ++i) { sc[kb][i] = __builtin_amdgcn_exp2f(sc[kb][i] - m_new); ps += sc[kb][i]; } \
            l_run = l_run * alpha + ps; \
            _Pragma("unroll") for (int i = 0; i < 8; ++i) o[i] *= alpha; \
            bf16x8 pf[2]; \
            _Pragma("unroll") for (int kp = 0; kp < 2; ++kp) { \
                u32x4 w; w.x = cvt_pk_bf16(sc[2 * kp][0], sc[2 * kp][1]); w.y = cvt_pk_bf16(sc[2 * kp][2], sc[2 * kp][3]); \
                w.z = cvt_pk_bf16(sc[2 * kp + 1][0], sc[2 * kp + 1][1]); w.w = cvt_pk_bf16(sc[2 * kp + 1][2], sc[2 * kp + 1][3]); \
                pf[kp] = __builtin_bit_cast(bf16x8, w); } \
            _Pragma("unroll") for (int db = 0; db < 8; ++db) { \
                const LAS unsigned char* vp = lds + (cur) + AT_KT + (16 * db + l15) * AT_VROW + g4 * 16; \
                _Pragma("unroll") for (int kp = 0; kp < 2; ++kp) { \
                    const bf16x8 vf = *(const LAS bf16x8*)(vp + kp * 64); \
                    o[db] = __builtin_amdgcn_mfma_f32_16x16x32_bf16(vf, pf[kp], o[db], 0, 0, 0); } } \
        } while (0)
        for (int t = 0; t < ntile; t += 2) {
            if (t + 2 < ntile) AT_LOAD(kb_, vb_, t + 2);
            AT_STEP(0);
            AT_STORE(ka_, va_, AT_STAGE);
            __syncthreads();
            if (t + 3 < ntile) AT_LOAD(ka_, va_, t + 3);
            AT_STEP(AT_STAGE);
            if (t + 2 < ntile) AT_STORE(kb_, vb_, 0);
            __syncthreads();
        }
#undef AT_LOAD
#undef AT_STORE
#undef AT_STEP
        const float inv = 1.0f / xg_sum(l_run);
        bf16_t* op = O + (size_t)(qrow0 + wave * 16 + l15) * D + h * 128 + 4 * g4;
#pragma unroll
        for (int db = 0; db < 8; ++db) { u32x2 w; w.x = cvt_pk_bf16(o[db][0] * inv, o[db][1] * inv); w.y = cvt_pk_bf16(o[db][2] * inv, o[db][3] * inv); *(u32x2*)(op + 16 * db) = w; }
    }
}

constexpr int S5_ROW = 288, S5_SUB = 16 * S5_ROW, S5_WAVE = 2 * S5_SUB + 2048, S5_FIN = 8 * S5_WAVE;
struct S5Consts { bf16x8 bfr[4]; bf16x8 cfr[4]; float ar[2], ai[2]; };
__device__ __forceinline__ void s5_consts(KA ka, int g, int d, int lane, S5Consts& K) {
    const int pl = lane & 31, hh = lane >> 5, l15 = lane & 15, g4 = lane >> 4;
    const float dt = expf(IN_(I_LOGDT)[d * 128 + g]);
#pragma unroll
    for (int s = 0; s < 2; ++s) {
        const int p = pl + 32 * s; const size_t pi = (size_t)(d * 128 + g) * 64 + p;
        const float lr = IN_(I_ARE)[pi], li = IN_(I_AIM)[pi];
        const float er = expf(lr * dt); float sn, cs; sincosf(li * dt, &sn, &cs);
        const float abr = er * cs, abi = er * sn;
        K.ar[s] = abr; K.ai[s] = abi;
        const float nr = abr - 1.0f, ni = abi, den = 1.0f / (lr * lr + li * li);
        const float cr = (nr * lr + ni * li) * den, ci = (ni * lr - nr * li) * den;
        const f32x4 b0 = *(const f32x4*)(IN_(I_BRE) + pi * 16 + 8 * hh), b1 = *(const f32x4*)(IN_(I_BRE) + pi * 16 + 8 * hh + 4);
        const f32x4 c0 = *(const f32x4*)(IN_(I_BIM) + pi * 16 + 8 * hh), c1 = *(const f32x4*)(IN_(I_BIM) + pi * 16 + 8 * hh + 4);
        u32x4 wr_, wi_;
        wr_.x = cvt_pk_bf16(cr * b0[0] - ci * c0[0], cr * b0[1] - ci * c0[1]); wr_.y = cvt_pk_bf16(cr * b0[2] - ci * c0[2], cr * b0[3] - ci * c0[3]);
        wr_.z = cvt_pk_bf16(cr * b1[0] - ci * c1[0], cr * b1[1] - ci * c1[1]); wr_.w = cvt_pk_bf16(cr * b1[2] - ci * c1[2], cr * b1[3] - ci * c1[3]);
        wi_.x = cvt_pk_bf16(cr * c0[0] + ci * b0[0], cr * c0[1] + ci * b0[1]); wi_.y = cvt_pk_bf16(cr * c0[2] + ci * b0[2], cr * c0[3] + ci * b0[3]);
        wi_.z = cvt_pk_bf16(cr * c1[0] + ci * b1[0], cr * c1[1] + ci * b1[1]); wi_.w = cvt_pk_bf16(cr * c1[2] + ci * b1[2], cr * c1[3] + ci * b1[3]);
        K.bfr[s] = __builtin_bit_cast(bf16x8, wr_); K.bfr[2 + s] = __builtin_bit_cast(bf16x8, wi_);
    }
#pragma unroll
    for (int ks = 0; ks < 4; ++ks) {
        const size_t ci = ((size_t)(d * 128 + g) * 16 + l15) * 64 + 16 * ks + 4 * g4;
        const f32x4 cr = *(const f32x4*)(IN_(I_CRE) + ci), cm = *(const f32x4*)(IN_(I_CIM) + ci);
        u32x4 w; w.x = cvt_pk_bf16(cr[0], -cm[0]); w.y = cvt_pk_bf16(cr[1], -cm[1]); w.z = cvt_pk_bf16(cr[2], -cm[2]); w.w = cvt_pk_bf16(cr[3], -cm[3]);
        K.cfr[ks] = __builtin_bit_cast(bf16x8, w);
    }
}
template <int MODE, bool BWD>
__device__ __forceinline__ void s5_pass(KA ka, int lane, int g, int rowb0, int rowb1, int nchunk, const S5Consts& K, bf16x8 dfr, float (&hr)[2], float (&hi)[2], LAS unsigned char* hsb) {
    const int pl = lane & 31, hh = lane >> 5, l15 = lane & 15, g4 = lane >> 4;
    const bf16_t* H = (const bf16_t*)(WS_ + WS_H); float* YS = (float*)(WS_ + WS_YST); bf16_t* G = (bf16_t*)(WS_ + WS_G);
    const int a_sub = (pl >> 2) & 1, a_idx = 4 * (pl >> 3) + (pl & 3);
    const bf16_t* ap = H + (size_t)((a_sub ? rowb1 : rowb0) + a_idx) * D + g * 16 + 8 * hh;
    const int t_first = BWD ? 16 * (nchunk - 1) : 0, t_step = BWD ? -16 : 16;
    bf16x8 a_cur = *(const bf16x8*)(ap + (size_t)t_first * D);
    float xr[2] = {hr[0], hr[1]}, xi[2] = {hi[0], hi[1]};
#pragma unroll 1
    for (int c = 0; c < nchunk; ++c) {
        const int t0 = t_first + c * t_step;
        bf16x8 a_nxt = a_cur;
        if (c + 1 < nchunk) a_nxt = *(const bf16x8*)(ap + (size_t)(t0 + t_step) * D);
        float st[2][4]; bf16x8 ua[2];
        if (MODE == 2) {
#pragma unroll
            for (int sb = 0; sb < 2; ++sb) {
                const int rb = (sb ? rowb1 : rowb0) + t0;
#pragma unroll
                for (int i = 0; i < 4; ++i) st[sb][i] = __hip_atomic_load(YS + ((size_t)g * MT + rb + 4 * g4 + i) * 16 + l15, __ATOMIC_RELAXED, __HIP_MEMORY_SCOPE_AGENT);
                const u32x4 z = {0u, 0u, 0u, 0u};
                ua[sb] = __builtin_bit_cast(bf16x8, z);
                if (g4 < 2) ua[sb] = *(const bf16x8*)(H + (size_t)(rb + l15) * D + g * 16 + 8 * g4);
            }
        }
        const f32x16 z16 = {0.f,0.f,0.f,0.f,0.f,0.f,0.f,0.f,0.f,0.f,0.f,0.f,0.f,0.f,0.f,0.f};
#pragma unroll
        for (int s = 0; s < 2; ++s) {
            const f32x16 br_ = __builtin_amdgcn_mfma_f32_32x32x16_bf16(a_cur, K.bfr[s], z16, 0, 0, 0);
            const f32x16 bi_ = __builtin_amdgcn_mfma_f32_32x32x16_bf16(a_cur, K.bfr[2 + s], z16, 0, 0, 0);
            f32x2 x = {xr[s], xi[s]}; const f32x2 ca = {K.ar[s], K.ar[s]}, cb = {-K.ai[s], K.ai[s]};
            LAS unsigned* hw = (LAS unsigned*)(hsb + hh * S5_SUB) + pl + 32 * s;
#pragma unroll
            for (int ii = 0; ii < 16; ++ii) {
                const int i = BWD ? 15 - ii : ii;
                const f32x2 u = {br_[i], bi_[i]}; const f32x2 xs = {x.y, x.x};
                x = ca * x + (cb * xs + u);
                if (MODE != 0) hw[i * (S5_ROW / 4)] = cvt_pk_bf16(x.x, x.y);
            }
            xr[s] = x.x; xi[s] = x.y;
        }
        if (MODE != 0) {
            asm volatile("s_waitcnt lgkmcnt(0)" ::: "memory");
            f32x4 y[2];
#pragma unroll
            for (int sb = 0; sb < 2; ++sb) {
                f32x4 a = {0.f, 0.f, 0.f, 0.f};
                const LAS unsigned char* hp = hsb + sb * S5_SUB + l15 * S5_ROW + g4 * 16;
#pragma unroll
                for (int ks = 0; ks < 4; ++ks) { const bf16x8 hf = *(const LAS bf16x8*)(hp + ks * 64); a = __builtin_amdgcn_mfma_f32_16x16x32_bf16(hf, K.cfr[ks], a, 0, 0, 0); }
                if (MODE == 2) a = __builtin_amdgcn_mfma_f32_16x16x32_bf16(ua[sb], dfr, a, 0, 0, 0);
                y[sb] = a;
            }
            if (MODE == 1) {
#pragma unroll
                for (int sb = 0; sb < 2; ++sb) { const int rb = (sb ? rowb1 : rowb0) + t0;
#pragma unroll
                    for (int i = 0; i < 4; ++i) YS[((size_t)g * MT + rb + 4 * g4 + i) * 16 + l15] = y[sb][i]; }
            } else {
                LAS float* tl = (LAS float*)(hsb + 2 * S5_SUB);
#pragma unroll
                for (int sb = 0; sb < 2; ++sb)
#pragma unroll
                    for (int i = 0; i < 4; ++i) tl[sb * 256 + (4 * g4 + i) * 16 + l15] = gelu_tanh_f(y[sb][i] + st[sb][i]);
                asm volatile("s_waitcnt lgkmcnt(0)" ::: "memory");
                const int tt = pl >> 1, hf = pl & 1;
                const f32x4 o0 = *(const LAS f32x4*)(tl + hh * 256 + tt * 16 + hf * 8), o1 = *(const LAS f32x4*)(tl + hh * 256 + tt * 16 + hf * 8 + 4);
                u32x4 o; o.x = cvt_pk_bf16(o0[0], o0[1]); o.y = cvt_pk_bf16(o0[2], o0[3]); o.z = cvt_pk_bf16(o1[0], o1[1]); o.w = cvt_pk_bf16(o1[2], o1[3]);
                *(u32x4*)(G + (size_t)((hh ? rowb1 : rowb0) + t0 + tt) * D + g * 16 + 8 * hf) = o;
                asm volatile("s_waitcnt lgkmcnt(0)" ::: "memory");
            }
        }
        a_cur = a_nxt;
    }
    if (MODE == 1) asm volatile("s_waitcnt vmcnt(0)" ::: "memory");
    hr[0] = xr[0]; hr[1] = xr[1]; hi[0] = xi[0]; hi[1] = xi[1];
}
__device__ __forceinline__ bf16x8 s5_dfr(KA ka, int g, int lane) {
    const int l15 = lane & 15, g4 = lane >> 4; const float dk = IN_(I_S5D)[g * 16 + l15];
    u32x4 w;
    w.x = cvt_pk_bf16((8 * g4 + 0 == l15) ? dk : 0.f, (8 * g4 + 1 == l15) ? dk : 0.f); w.y = cvt_pk_bf16((8 * g4 + 2 == l15) ? dk : 0.f, (8 * g4 + 3 == l15) ? dk : 0.f);
    w.z = cvt_pk_bf16((8 * g4 + 4 == l15) ? dk : 0.f, (8 * g4 + 5 == l15) ? dk : 0.f); w.w = cvt_pk_bf16((8 * g4 + 6 == l15) ? dk : 0.f, (8 * g4 + 7 == l15) ? dk : 0.f);
    return __builtin_bit_cast(bf16x8, w);
}
__device__ __forceinline__ void phase_s5(Frame& F) {
    KA ka = get_ka();
    const int lane = F.lane, wave = F.wave, pl = lane & 31, hh = lane >> 5;
    LAS unsigned char* hsb = F.lds + wave * S5_WAVE;
    if (F.vcu < 128) {
        const int g = F.vcu;
        LAS float* fin = (LAS float*)(F.lds + S5_FIN);
        const int rowb0 = MCTX + 128 * wave, rowb1 = MCTX + 1024 + 128 * wave;
        const bf16x8 dfr = s5_dfr(ka, g, lane);
#pragma unroll 1
        for (int d = 0; d < 2; ++d) {
            S5Consts K; s5_consts(ka, g, d, lane, K);
            float hr[2] = {0.f, 0.f}, hi[2] = {0.f, 0.f};
            if (d == 0) s5_pass<0, false>(ka, lane, g, rowb0, rowb1, 8, K, dfr, hr, hi, hsb);
            else s5_pass<0, true>(ka, lane, g, rowb0, rowb1, 8, K, dfr, hr, hi, hsb);
#pragma unroll
            for (int s = 0; s < 2; ++s) { LAS float* fp = fin + (((d * 8 + wave) * 2 + hh) * 64 + pl + 32 * s) * 2; fp[0] = hr[s]; fp[1] = hi[s]; }
        }
        __syncthreads();
#pragma unroll 1
        for (int d = 0; d < 2; ++d) {
            S5Consts K; s5_consts(ka, g, d, lane, K);
            float hr[2], hi[2];
#pragma unroll
            for (int s = 0; s < 2; ++s) {
                float pr = K.ar[s], pi_ = K.ai[s];
#pragma unroll
                for (int q = 0; q < 7; ++q) { const float nr = pr * pr - pi_ * pi_, ni = 2.0f * pr * pi_; pr = nr; pi_ = ni; }
                const size_t si = ((size_t)(hh * 2 + d) * 128 + g) * 64 + pl + 32 * s;
                float cr = IN_(I_SRE)[si], ci = IN_(I_SIM)[si];
#pragma unroll 1
                for (int q = 0; q < 7; ++q) {
                    const int sg = d ? 7 - q : q;
                    const bool take = d ? (sg > wave) : (sg < wave);
                    const LAS float* fp = fin + (((d * 8 + sg) * 2 + hh) * 64 + pl + 32 * s) * 2;
                    const float fr = fp[0], fi = fp[1];
                    const float nr = pr * cr - pi_ * ci + fr, ni = pr * ci + pi_ * cr + fi;
                    if (take) { cr = nr; ci = ni; }
                }
                hr[s] = cr; hi[s] = ci;
            }
            if (d == 0) s5_pass<1, false>(ka, lane, g, rowb0, rowb1, 8, K, dfr, hr, hi, hsb);
            else s5_pass<2, true>(ka, lane, g, rowb0, rowb1, 8, K, dfr, hr, hi, hsb);
        }
        __syncthreads();
        convert_slot(F, ka, 6, F.vcu * 8 + wave, 128 * 8);
    } else {
#pragma unroll 1
        for (int item = (F.vcu - 128) * 8 + wave; item < 1024; item += (F.G - 128) * 8) {
            const int g = item >> 3, pr_ = item & 7;
            const int rowb0 = (2 * pr_) * 256, rowb1 = (2 * pr_ + 1) * 256;
            const bf16x8 dfr = s5_dfr(ka, g, lane);
#pragma unroll 1
            for (int d = 0; d < 2; ++d) {
                S5Consts K; s5_consts(ka, g, d, lane, K);
                float hr[2] = {0.f, 0.f}, hi[2] = {0.f, 0.f};
                if (d == 0) s5_pass<1, false>(ka, lane, g, rowb0, rowb1, 16, K, dfr, hr, hi, hsb);
                else s5_pass<2, true>(ka, lane, g, rowb0, rowb1, 16, K, dfr, hr, hi, hsb);
#pragma unroll
                for (int s = 0; s < 2; ++s) { const size_t si = ((size_t)((2 * pr_ + hh) * 2 + d) * 128 + g) * 64 + pl + 32 * s; OUT_[OUT_SRE + si] = hr[s]; OUT_[OUT_SIM + si] = hi[s]; }
            }
        }
    }
}

constexpr int NPH = 23;

__device__ __forceinline__ void gemm_ffn_in(Frame& F, int fi) {
    KA ka = get_ka();
    pg8::Gemm g{(const bf16_t*)(WS_ + WS_H), (const bf16_t*)(WS_ + WS_WIN) + (size_t)fi * NFF2 * D, MT, NFF2, D};
#ifndef G1_MB
#define G1_MB 4
#endif
    pg8::EpiSwiGLU E{(bf16_t*)(WS_ + WS_ACT)};
    if (fi == 3) {
        pg8::Ffn3MainOrder S1{F.G, (int)blockIdx.x};
        pg8::gemm_phase<pg8::EpiSwiGLU, pg8::Ffn3MainOrder, true, true, 3>(F.lds, g, S1, E);
        if (F.vcu < 192) { pg8::Ffn3TailOrder S2{F.vcu}; pg8::gemm_phase<pg8::EpiSwiGLU, pg8::Ffn3TailOrder, true, true, 2>(F.lds, g, S2, E); }
        else convert_slot(F, ka, 5, (F.vcu - 192) * 8 + F.wave, (F.G - 192) * 8);
        return;
    }
    pg8::StaticOrder S; S.init(MT, NFF2, F.G, (int)blockIdx.x, 192);
    pg8::gemm_phase<pg8::EpiSwiGLU, pg8::StaticOrder, true, true, 3>(F.lds, g, S, E);
    if ((int)blockIdx.x >= 128) convert_slot(F, ka, fi == 0 ? 1 : fi + 2, ((int)blockIdx.x - 128) * 8 + F.wave, (F.G - 128) * 8);
}
__device__ __forceinline__ void gemm_ffn_out(Frame& F, int l, int sub, bool first_sub) {
    KA ka = get_ka();
    const int fi = l * 2 + (sub == 2 ? 1 : 0);
    bf16_t* X = (bf16_t*)(WS_ + WS_X);
    pg8::Gemm g{(const bf16_t*)(WS_ + WS_ACT), (const bf16_t*)(WS_ + WS_WOUT) + (size_t)fi * D * DFF, MT, D, DFF};
    pg8::StaticOrder S; S.init(MT, D, F.G, (int)blockIdx.x, 192);
    if (first_sub) {
        pg8::EpiResT<true> E{IN_(I_XP), IN_(I_XS) - (size_t)MCTX * D, X, MODS_ + (size_t)l * 3 * NMOD + (sub * 3 + 2) * D, 0.5f};
        pg8::gemm_phase<pg8::EpiResT<true>, pg8::StaticOrder, true, true, 3>(F.lds, g, S, E);
    } else {
        pg8::EpiResT<false> E{X, X, X, MODS_ + (size_t)l * 3 * NMOD + (sub * 3 + 2) * D, 0.5f};
        pg8::gemm_phase<pg8::EpiResT<false>, pg8::StaticOrder, true, true, 3>(F.lds, g, S, E);
    }
}
__device__ __forceinline__ void gemm_wo(Frame& F) {
    KA ka = get_ka();
    bf16_t* X = (bf16_t*)(WS_ + WS_X);
    pg8::Gemm g{(const bf16_t*)(WS_ + WS_O), (const bf16_t*)(WS_ + WS_WO), MT, D, D};
    pg8::StaticOrder S; S.init(MT, D, F.G, (int)blockIdx.x, 192);
    pg8::EpiResT<false> E{X, X, X, MODS_ + (size_t)(1 * 3 + 2) * D, 1.0f};
    pg8::gemm_phase<pg8::EpiResT<false>, pg8::StaticOrder, true, true, 3>(F.lds, g, S, E);
}
__device__ __forceinline__ void gemm_ga(Frame& F) {
    KA ka = get_ka();
    pg8::Gemm g{(const bf16_t*)(WS_ + WS_H), (const bf16_t*)(WS_ + WS_WA), MT, NA, D};
    pg8::StaticOrder S; S.init(MT, NA, F.G, (int)blockIdx.x, 192);
    pg8::EpiF32 E{(bf16_t*)(WS_ + WS_CQKV), NA};
    pg8::gemm_phase<pg8::EpiF32, pg8::StaticOrder, true, true, 3>(F.lds, g, S, E);
    if ((int)blockIdx.x >= 192) convert_slot(F, ka, 2, ((int)blockIdx.x - 192) * 8 + F.wave, (F.G - 192) * 8);
}
__device__ __forceinline__ void gemm_q(Frame& F) {
    KA ka = get_ka();
    pg8::Gemm g{(const bf16_t*)(WS_ + WS_CQ), (const bf16_t*)(WS_ + WS_WUQ), MT, NQ, QL};
    pg8::StaticOrder S; S.init(MT, NQ, F.G, (int)blockIdx.x);
    pg8::EpiQ E{(bf16_t*)(WS_ + WS_Q), ROPEC_, ROPES_};
    pg8::gemm_phase<pg8::EpiQ, pg8::StaticOrder, true, true>(F.lds, g, S, E);
}
__device__ __forceinline__ void gemm_kn(Frame& F) {
    KA ka = get_ka();
    pg8::Gemm g{(const bf16_t*)(WS_ + WS_CKV), (const bf16_t*)(WS_ + WS_WUK), KVR, D, KVL};
    pg8::StaticOrder S; S.init(KVR, D, F.G, (int)((blockIdx.x + 224) % F.G));
    pg8::EpiBf16 E{(bf16_t*)(WS_ + WS_KN), D};
    pg8::gemm_phase<pg8::EpiBf16, pg8::StaticOrder, true, true>(F.lds, g, S, E);
}
__device__ __forceinline__ void gemm_vt(Frame& F) {
    KA ka = get_ka();
    pg8::Gemm g{(const bf16_t*)(WS_ + WS_WUV), (const bf16_t*)(WS_ + WS_CKV), D, KVR, KVL};
    pg8::StaticOrder S; S.init(D, KVR, F.G, (int)((blockIdx.x + 208) % F.G));
    pg8::EpiBf16 E{(bf16_t*)(WS_ + WS_VT), KVR};
    pg8::gemm_phase<pg8::EpiBf16, pg8::StaticOrder, true, true>(F.lds, g, S, E);
}
__device__ __forceinline__ void gemm_glu(Frame& F) {
    KA ka = get_ka();
    bf16_t* X = (bf16_t*)(WS_ + WS_X);
    pg8::Gemm g{(const bf16_t*)(WS_ + WS_G), (const bf16_t*)(WS_ + WS_WGLU), MT, 4096, D};
    pg8::StaticOrder S; S.init(MT, 4096, F.G, (int)blockIdx.x, 192);
    pg8::EpiGLU E{X, X, MODS_ + (size_t)1 * 3 * NMOD + (1 * 3 + 2) * D};
    pg8::gemm_phase<pg8::EpiGLU, pg8::StaticOrder, true, true, 3>(F.lds, g, S, E);
}

__global__ void __launch_bounds__(512, 2) mk_fwd(Args args) {
    extern __shared__ __attribute__((aligned(16))) unsigned char lds_raw[];
    Frame F;
    F.lds = (LAS unsigned char*)lds_raw;
    F.tid = threadIdx.x; F.lane = F.tid & 63; F.wave = __builtin_amdgcn_readfirstlane(F.tid >> 6);
    F.G = gridDim.x; { const int bx = blockIdx.x; F.vcu = (F.G % 8 == 0) ? (bx % 8) * (F.G / 8) + bx / 8 : bx; }
    volatile LAS unsigned* MISC = (volatile LAS unsigned*)(F.lds + MISC_OFF);
    if (F.tid < 32) MISC[F.tid] = 0u;
    __syncthreads();
    const int lo = args.ph_lo, hi = args.ph_hi; const bool use_bar = args.use_bar != 0;
    XcdBarrier bar; bar.bar = (unsigned*)(args.ws + WS_CTL) + 1024; bar.x = 0; bar.st = nullptr;
    if (use_bar) bar = xcd_barrier_post((unsigned*)(args.ws + WS_CTL) + 1024, MISC + 8);
#define IN(k) (lo <= (k) && (k) < hi)
#define SEAM(k) do { if ((k) + 1 < hi) { if (use_bar) xcd_barrier(bar); else __syncthreads(); } } while (0)
#ifndef REP_PH
#define REP_PH -1
#define REP_N 0
#endif
#define PHASE(k, body) do { if (IN(k)) { for (int r_ = 0; r_ < ((k) == REP_PH ? REP_N : 0); ++r_) { body; if (use_bar) xcd_barrier(bar); else __syncthreads(); } body; SEAM(k); } } while (0)
    PHASE(0, phase_prologue(F));
    PHASE(1, phase_norm(F, 0, 0, true));
    PHASE(2, gemm_ffn_in(F, 0));
    PHASE(3, gemm_ffn_out(F, 0, 0, true));
    PHASE(4, phase_norm(F, 0, 1, false));
    PHASE(5, gemm_ga(F));
    PHASE(6, phase_mla_norm(F));
    PHASE(7, { gemm_q(F); gemm_kn(F); gemm_vt(F); });
    PHASE(8, phase_attn(F));
    PHASE(9, gemm_wo(F));
    PHASE(10, phase_norm(F, 0, 2, false));
    PHASE(11, gemm_ffn_in(F, 1));
    PHASE(12, gemm_ffn_out(F, 0, 2, false));
    PHASE(13, phase_norm(F, 1, 0, false));
    PHASE(14, gemm_ffn_in(F, 2));
    PHASE(15, gemm_ffn_out(F, 1, 0, false));
    PHASE(16, phase_norm(F, 1, 1, false));
    PHASE(17, phase_s5(F));
    PHASE(18, gemm_glu(F));
    PHASE(19, phase_norm(F, 1, 2, false));
    PHASE(20, gemm_ffn_in(F, 3));
    PHASE(21, gemm_ffn_out(F, 1, 2, false));
    PHASE(22, phase_final(F));
#undef IN
#undef SEAM
#undef PHASE
}

extern "C" void kernel_launch(void* const* d_in, const int* in_sizes, int n_in, void* d_out, int out_size, void* d_ws, size_t ws_size, hipStream_t stream) {
    static int grid = 0;
    if (grid == 0) {
        if (n_in != 30 || ws_size < WS_END) { fprintf(stderr, "kernel_launch: unexpected n_in %d / ws_size %zu\n", n_in, ws_size); grid = -1; return; }
        int dev = 0, cus = 0, per_cu = 0;
        if (hipGetDevice(&dev) != hipSuccess || hipDeviceGetAttribute(&cus, hipDeviceAttributeMultiprocessorCount, dev) != hipSuccess) { grid = -1; return; }
        if (hipFuncSetAttribute((const void*)mk_fwd, hipFuncAttributeMaxDynamicSharedMemorySize, LDS_BYTES) != hipSuccess) { fprintf(stderr, "kernel_launch: hipFuncSetAttribute failed\n"); grid = -1; return; }
        if (hipOccupancyMaxActiveBlocksPerMultiprocessor(&per_cu, (const void*)mk_fwd, 512, LDS_BYTES) != hipSuccess || per_cu < 1) { fprintf(stderr, "kernel_launch: occupancy query says %d blocks per CU\n", per_cu); per_cu = 1; }
        (void)hipGetLastError();
        grid = cus;
    }
    if (grid < 0) return;
    (void)hipMemsetAsync((char*)d_ws + WS_CTL, 0, CTL_ZERO_BYTES, stream);
    Args a{};
    for (int i = 0; i < 30; ++i) a.in[i] = (const float*)d_in[i];
    a.out = (float*)d_out; a.ws = (unsigned char*)d_ws;
#if MK_PER_PHASE
    for (int ph = 0; ph < NPH; ++ph) {
        a.ph_lo = ph; a.ph_hi = ph + 1; a.use_bar = 0;
        hipLaunchKernelGGL(mk_fwd, dim3(grid), dim3(512), LDS_BYTES, stream, a);
    }
#else
    a.ph_lo = 0; a.ph_hi = NPH; a.use_bar = 1;
    void* kargs[] = {&a};
    hipError_t e = hipLaunchCooperativeKernel((const void*)mk_fwd, dim3(grid), dim3(512), kargs, LDS_BYTES, stream);
    if (e != hipSuccess) fprintf(stderr, "kernel_launch: cooperative launch failed: %s (grid %d)\n", hipGetErrorString(e), grid);
#endif
}
```

```cpp
#include <hip/hip_runtime.h>
#include <cstdio>
#include <cstdint>

#ifndef MK_PER_PHASE
#define MK_PER_PHASE 0
#endif

#define LAS __attribute__((address_space(3)))
#define GAS __attribute__((address_space(1)))
typedef unsigned short bf16_t;
typedef short bf16x8 __attribute__((ext_vector_type(8)));
typedef short bf16x4 __attribute__((ext_vector_type(4)));
typedef float f32x4 __attribute__((ext_vector_type(4)));
typedef float f32x2 __attribute__((ext_vector_type(2)));
typedef float f32x16 __attribute__((ext_vector_type(16)));
typedef unsigned u32x4 __attribute__((ext_vector_type(4)));
typedef unsigned u32x2 __attribute__((ext_vector_type(2)));

constexpr int D = 2048, MT = 6144, MCTX = 4096, DFF = 5632, NFF2 = 11264, NMOD = 18432;
constexpr int KVR = 6656;
constexpr int NQ = 3072, NA = 1536, QL = 768, KVL = 512;
constexpr float EPS = 1e-6f;
constexpr float QSCALE = 0.07216878364870322f * 1.4426950408889634f;

constexpr size_t MiB = 1u << 20;
constexpr size_t WS_CTL = 0, CTL_ZERO_BYTES = 64 * 1024;
constexpr size_t WS_MODS = 1 * MiB;
constexpr size_t WS_ROPE = 2 * MiB;
constexpr size_t WS_WIN = 16 * MiB;
constexpr size_t WS_WOUT = 192 * MiB;
constexpr size_t WS_WA = 280 * MiB;
constexpr size_t WS_WUQ = 286 * MiB;
constexpr size_t WS_WUK = 291 * MiB;
constexpr size_t WS_WUV = 293 * MiB;
constexpr size_t WS_WO = 295 * MiB;
constexpr size_t WS_WGLU = 303 * MiB;
constexpr size_t WS_X = 320 * MiB;
constexpr size_t WS_H = 368 * MiB;
constexpr size_t WS_ACT = 392 * MiB;
constexpr size_t WS_CQKV = 458 * MiB;
constexpr size_t WS_CQ = 494 * MiB;
constexpr size_t WS_CKV = 503 * MiB;
constexpr size_t WS_KPE = 510 * MiB;
constexpr size_t WS_Q = 511 * MiB;
constexpr size_t WS_KN = 547 * MiB;
constexpr size_t WS_VT = 573 * MiB;
constexpr size_t WS_O = 599 * MiB;
constexpr size_t WS_YST = 623 * MiB;
constexpr size_t WS_G = 671 * MiB;
constexpr size_t WS_END = 696 * MiB;

constexpr size_t OUT_Y = 0, OUT_CKV = 12582912, OUT_KPE = 14680064, OUT_SRE = 14942208, OUT_SIM = 15204352;

constexpr int LDS_BYTES = 147456;
constexpr int MISC_OFF = 131072 + 320;

typedef __bf16 bf16x2_t __attribute__((ext_vector_type(2)));
__device__ __forceinline__ unsigned cvt_pk_bf16(float lo, float hi) { const f32x2 v = {lo, hi}; const bf16x2_t b = __builtin_convertvector(v, bf16x2_t); return __builtin_bit_cast(unsigned, b); }
__device__ __forceinline__ float wave_sum(float v) {
#pragma unroll
    for (int o = 1; o < 64; o <<= 1) v += __shfl_xor(v, o);
    return v;
}
__device__ __forceinline__ float silu_f(float v) { return v * __builtin_amdgcn_rcpf(1.0f + __expf(-v)); }
__device__ __forceinline__ float sigmoid_f(float v) { return __builtin_amdgcn_rcpf(1.0f + __expf(-v)); }
__device__ __forceinline__ float gelu_tanh_f(float x) {
    const float k0 = -2.0f * 0.7978845608028654f * 1.4426950408889634f, k1 = k0 * 0.044715f;
    const float t = x * x;
    return x * __builtin_amdgcn_rcpf(1.0f + __builtin_amdgcn_exp2f(x * (k0 + k1 * t)));
}
__device__ __forceinline__ int tile_ms(int pm) { return pm < 16 ? 0 : 1 + ((pm - 16) >> 2); }

namespace pg8 {
constexpr int BM = 256, BK = 64, HALF = 128, HTB = HALF * BK * 2, STAGE_BYTES = 8 * HTB, NXCD = 8, WGM = 8;
__host__ __device__ __forceinline__ int lds_byte(int r, int c) { const int st = (r >> 4) * 2 + (c >> 5), rr = r & 15, cc = c & 31, ob = rr * 64 + cc * 2; return st * 1024 + (ob ^ (((ob >> 9) & 1) << 5)); }
__host__ __device__ __forceinline__ void stage_rc(int b, int& R, int& C) { const int st = b / 1024, sb = b % 1024, swz = sb ^ (((sb >> 9) & 1) << 5); R = (st >> 1) * 16 + swz / 64; C = (st & 1) * 32 + (swz % 64) / 2; }
__host__ __device__ __forceinline__ int perm32(int rho) { const int n = rho >> 4, i = rho & 15; return 8 * (i >> 2) + 4 * n + (i & 3); }

struct Unit { int pm, pn; };
struct Gemm { const bf16_t* A; const bf16_t* Bt; int M, N, K; };

struct StaticOrder {
    int nM, nN, nwg, G, c;
    __host__ __device__ void init(int M, int N, int G_, int c_, int rows = BM) { nM = M / rows; nN = N / BM; nwg = nM * nN; G = G_; c = c_; }
    __host__ __device__ bool next(int i, Unit& u) const {
        const long L = (long)i * G + c; if (L >= nwg) return false;
        int wgid = (int)L; { const int q = nwg / NXCD, r = nwg % NXCD, xcd = wgid % NXCD, off = wgid / NXCD; wgid = (xcd < r ? xcd * (q + 1) : r * (q + 1) + (xcd - r) * q) + off; }
        const int nig = WGM * nN, gid = wgid / nig, fm = gid * WGM, gsz = (nM - fm) < WGM ? (nM - fm) : WGM;
        u.pm = fm + ((wgid % nig) % gsz); u.pn = (wgid % nig) / gsz; return true;
    }
    __device__ __forceinline__ void a_ready(const Unit&) const {}
    __device__ __forceinline__ void done(const Unit&) const {}
};

struct FfnMainOrder {
    int G, c;
    __device__ bool next(int i, Unit& u) const {
        const int L = i * G + c; if (L >= 1024) return false;
        const int w0 = (L % NXCD) * 128 + L / NXCD;
        if (w0 < 704) { const int gid = w0 / 352, w = w0 % 352; u.pm = 8 * gid + (w & 7); u.pn = w >> 3; }
        else { const int w = w0 - 704; u.pm = 16 + (w & 7); u.pn = w >> 3; }
        return true;
    }
    __device__ __forceinline__ void a_ready(const Unit&) const {}
    __device__ __forceinline__ void done(const Unit&) const {}
};
struct FfnTail2Order {
    int c;
    __device__ bool next(int i, Unit& u) const { if (i > 0 || c >= 64) return false; u.pm = 32 + (c >> 2); u.pn = 40 + (c & 3); return true; }
    __device__ __forceinline__ void a_ready(const Unit&) const {}
    __device__ __forceinline__ void done(const Unit&) const {}
};
struct FfnTailOrder {
    int c;
    __device__ bool next(int i, Unit& u) const { if (i > 0 || c >= 128) return false; u.pm = 64 + (c >> 2); u.pn = 40 + (c & 3); return true; }
    __device__ __forceinline__ void a_ready(const Unit&) const {}
    __device__ __forceinline__ void done(const Unit&) const {}
};

struct Ffn3MainOrder {
    int G, c;
    __device__ bool next(int i, Unit& u) const {
        const int L = i * G + c; if (L >= 1280) return false;
        const int w0 = (L % NXCD) * 160 + L / NXCD;
        const int gid = w0 / 320, w = w0 % 320; u.pm = 8 * gid + (w & 7); u.pn = w >> 3; return true;
    }
    __device__ __forceinline__ void a_ready(const Unit&) const {}
    __device__ __forceinline__ void done(const Unit&) const {}
};
struct Ffn3TailOrder {
    int c;
    __device__ bool next(int i, Unit& u) const { if (i > 0 || c >= 192) return false; u.pm = c >> 2; u.pn = 40 + (c & 3); return true; }
    __device__ __forceinline__ void a_ready(const Unit&) const {}
    __device__ __forceinline__ void done(const Unit&) const {}
};


struct EpiSwiGLU {
    static constexpr bool PERM = true, AFTER_DRAIN = false;
    bf16_t* O;
    template <int MB>
    __device__ __forceinline__ void operator()(const f32x4 (&acc)[2][2][MB][2], const Unit& u, int wr, int wc, int fr, int fq) const {
        const int row0 = u.pm * 64 * MB + wr * 16 * MB + fr, col0 = u.pn * HALF + wc * 32 + 8 * fq;
#pragma unroll
        for (int ai = 0; ai < 2; ++ai)
#pragma unroll
            for (int m = 0; m < MB; ++m) {
                bf16_t* rowp = O + (size_t)(row0 + ai * 32 * MB + m * 16) * DFF + col0;
                const f32x4 g0 = acc[ai][0][m][0], g1 = acc[ai][0][m][1], u0 = acc[ai][1][m][0], u1 = acc[ai][1][m][1];
                f32x4 v0, v1;
#pragma unroll
                for (int j = 0; j < 4; ++j) { v0[j] = silu_f(g0[j]) * u0[j]; v1[j] = silu_f(g1[j]) * u1[j]; }
                u32x4 w; w.x = cvt_pk_bf16(v0[0], v0[1]); w.y = cvt_pk_bf16(v0[2], v0[3]); w.z = cvt_pk_bf16(v1[0], v1[1]); w.w = cvt_pk_bf16(v1[2], v1[3]);
                *(u32x4*)rowp = w;
            }
    }
};
__device__ __forceinline__ f32x4 bf4_f4(u32x2 r) { f32x4 o; o[0] = __uint_as_float(r.x << 16); o[1] = __uint_as_float(r.x & 0xffff0000u); o[2] = __uint_as_float(r.y << 16); o[3] = __uint_as_float(r.y & 0xffff0000u); return o; }
__device__ __forceinline__ int row_ms(int row) { return row < MCTX ? 0 : 1 + ((row - MCTX) >> 10); }
template <bool XF32>
struct EpiResT {
    static constexpr bool PERM = true, AFTER_DRAIN = false;
    const void* xa; const void* xb; bf16_t* xo; const float* gate; float coef;
    template <int MB>
    __device__ __forceinline__ void operator()(const f32x4 (&acc)[2][2][MB][2], const Unit& u, int wr, int wc, int fr, int fq) const {
        const int row0 = u.pm * 64 * MB + wr * 16 * MB + fr, col0 = u.pn * BM + wc * 32 + 8 * fq;
        const int ms0 = row_ms(u.pm * 64 * MB); const bool uni = ms0 == row_ms(u.pm * 64 * MB + 64 * MB - 1);
        f32x4 g0[2][2];
#pragma unroll
        for (int bj = 0; bj < 2; ++bj)
#pragma unroll
            for (int h = 0; h < 2; ++h) g0[bj][h] = *(const f32x4*)(gate + ms0 * NMOD + col0 + bj * HALF + 4 * h) * coef;
        u32x4 xh[XF32 ? 1 : 2][XF32 ? 1 : MB][2];
        if constexpr (!XF32) {
#pragma unroll
            for (int ai = 0; ai < 2; ++ai)
#pragma unroll
                for (int m = 0; m < MB; ++m) {
                    const int row = row0 + ai * 32 * MB + m * 16; const void* xin = (row < MCTX) ? xa : xb;
#pragma unroll
                    for (int bj = 0; bj < 2; ++bj) xh[ai][m][bj] = *(const u32x4*)((const bf16_t*)xin + (size_t)row * D + col0 + bj * HALF);
                }
        }
#pragma unroll
        for (int ai = 0; ai < 2; ++ai) {
            f32x4 xf[XF32 ? MB : 1][2][2];
            if constexpr (XF32) {
#pragma unroll
                for (int m = 0; m < MB; ++m) {
                    const int row = row0 + ai * 32 * MB + m * 16; const void* xin = (row < MCTX) ? xa : xb;
                    const size_t off = (size_t)row * D + col0;
#pragma unroll
                    for (int bj = 0; bj < 2; ++bj) { xf[m][bj][0] = *(const f32x4*)((const float*)xin + off + bj * HALF); xf[m][bj][1] = *(const f32x4*)((const float*)xin + off + bj * HALF + 4); }
                }
            }
#pragma unroll
            for (int m = 0; m < MB; ++m) {
                const int row = row0 + ai * 32 * MB + m * 16;
                const float* gv = gate + row_ms(row) * NMOD;
                const size_t off = (size_t)row * D + col0;
#pragma unroll
                for (int bj = 0; bj < 2; ++bj) {
                    f32x4 gt0 = g0[bj][0], gt1 = g0[bj][1];
                    if (!uni) { gt0 = *(const f32x4*)(gv + col0 + bj * HALF) * coef; gt1 = *(const f32x4*)(gv + col0 + bj * HALF + 4) * coef; }
                    f32x4 x0, x1;
                    if constexpr (XF32) { x0 = xf[m][bj][0]; x1 = xf[m][bj][1]; }
                    else { const u32x4 r = xh[ai][m][bj]; u32x2 lo; lo.x = r.x; lo.y = r.y; u32x2 hi; hi.x = r.z; hi.y = r.w; x0 = bf4_f4(lo); x1 = bf4_f4(hi); }
                    const f32x4 o0 = x0 + gt0 * acc[ai][bj][m][0], o1 = x1 + gt1 * acc[ai][bj][m][1];
                    u32x4 w; w.x = cvt_pk_bf16(o0[0], o0[1]); w.y = cvt_pk_bf16(o0[2], o0[3]); w.z = cvt_pk_bf16(o1[0], o1[1]); w.w = cvt_pk_bf16(o1[2], o1[3]);
                    *(u32x4*)(xo + off + bj * HALF) = w; }
            }
        }
    }
};
struct EpiGLU {
    static constexpr bool PERM = true, AFTER_DRAIN = false;
    const bf16_t* xin; bf16_t* xo; const float* gate;
    template <int MB>
    __device__ __forceinline__ void operator()(const f32x4 (&acc)[2][2][MB][2], const Unit& u, int wr, int wc, int fr, int fq) const {
        const int row0 = u.pm * 64 * MB + wr * 16 * MB + fr, col0 = u.pn * HALF + wc * 32 + 8 * fq;
        const int ms0 = row_ms(u.pm * 64 * MB); const bool uni = ms0 == row_ms(u.pm * 64 * MB + 64 * MB - 1);
        f32x4 g0[2];
#pragma unroll
        for (int h = 0; h < 2; ++h) g0[h] = *(const f32x4*)(gate + ms0 * NMOD + col0 + 4 * h);
        u32x4 xi[2][MB];
#pragma unroll
        for (int ai = 0; ai < 2; ++ai)
#pragma unroll
            for (int m = 0; m < MB; ++m) xi[ai][m] = *(const u32x4*)(xin + (size_t)(row0 + ai * 32 * MB + m * 16) * D + col0);
#pragma unroll
        for (int ai = 0; ai < 2; ++ai)
#pragma unroll
            for (int m = 0; m < MB; ++m) {
                const int row = row0 + ai * 32 * MB + m * 16;
                const float* gv = gate + row_ms(row) * NMOD;
                const size_t off = (size_t)row * D + col0;
                const u32x4 r = xi[ai][m]; u32x2 lo; lo.x = r.x; lo.y = r.y; u32x2 hi; hi.x = r.z; hi.y = r.w;
                f32x4 o[2];
#pragma unroll
                for (int h = 0; h < 2; ++h) {
                    f32x4 gt = g0[h]; if (!uni) gt = *(const f32x4*)(gv + col0 + 4 * h);
                    const f32x4 a = acc[ai][0][m][h], b = acc[ai][1][m][h], x4 = bf4_f4(h ? hi : lo);
#pragma unroll
                    for (int j = 0; j < 4; ++j) o[h][j] = x4[j] + gt[j] * a[j] * sigmoid_f(b[j]);
                }
                u32x4 w; w.x = cvt_pk_bf16(o[0][0], o[0][1]); w.y = cvt_pk_bf16(o[0][2], o[0][3]); w.z = cvt_pk_bf16(o[1][0], o[1][1]); w.w = cvt_pk_bf16(o[1][2], o[1][3]);
                *(u32x4*)(xo + off) = w;
            }
    }
};
struct EpiF32 {
    static constexpr bool PERM = true, AFTER_DRAIN = false;
    bf16_t* C; int ldc;
    template <int MB>
    __device__ __forceinline__ void operator()(const f32x4 (&acc)[2][2][MB][2], const Unit& u, int wr, int wc, int fr, int fq) const {
        const int row0 = u.pm * 64 * MB + wr * 16 * MB + fr, col0 = u.pn * BM + wc * 32 + 8 * fq;
#pragma unroll
        for (int ai = 0; ai < 2; ++ai)
#pragma unroll
            for (int m = 0; m < MB; ++m) { bf16_t* rowp = C + (size_t)(row0 + ai * 32 * MB + m * 16) * ldc + col0;
#pragma unroll
                for (int bj = 0; bj < 2; ++bj) { const f32x4 v0 = acc[ai][bj][m][0], v1 = acc[ai][bj][m][1];
                    u32x4 w; w.x = cvt_pk_bf16(v0[0], v0[1]); w.y = cvt_pk_bf16(v0[2], v0[3]); w.z = cvt_pk_bf16(v1[0], v1[1]); w.w = cvt_pk_bf16(v1[2], v1[3]);
                    *(u32x4*)(rowp + bj * HALF) = w; } }
    }
};
struct EpiBf16 {
    static constexpr bool PERM = true, AFTER_DRAIN = false;
    bf16_t* O; int ldc;
    template <int MB>
    __device__ __forceinline__ void operator()(const f32x4 (&acc)[2][2][4][2], const Unit& u, int wr, int wc, int fr, int fq) const {
        const int row0 = u.pm * BM + wr * 64 + fr, col0 = u.pn * BM + wc * 32 + 8 * fq;
#pragma unroll
        for (int ai = 0; ai < 2; ++ai)
#pragma unroll
            for (int m = 0; m < 4; ++m) { bf16_t* rowp = O + (size_t)(row0 + ai * HALF + m * 16) * ldc + col0;
#pragma unroll
                for (int bj = 0; bj < 2; ++bj) { const f32x4 v0 = acc[ai][bj][m][0], v1 = acc[ai][bj][m][1];
                    u32x4 w; w.x = cvt_pk_bf16(v0[0], v0[1]); w.y = cvt_pk_bf16(v0[2], v0[3]); w.z = cvt_pk_bf16(v1[0], v1[1]); w.w = cvt_pk_bf16(v1[2], v1[3]);
                    *(u32x4*)(rowp + bj * HALF) = w; } }
    }
};
struct EpiQ {
    static constexpr bool PERM = false, AFTER_DRAIN = false;
    bf16_t* Q; const float* rc; const float* rs;
    template <int MB>
    __device__ __forceinline__ void operator()(const f32x4 (&acc)[2][2][4][2], const Unit& u, int wr, int wc, int fr, int fq) const {
        const int row0 = u.pm * BM + wr * 64 + fr; const bool lat = u.pm >= 16;
#pragma unroll
        for (int bj = 0; bj < 2; ++bj) {
            const int gi = u.pn * 8 + bj * 4 + wc, sub = gi % 6; const bool pe = lat && (sub >= 4);
            const int colb = gi * 32 + 4 * fq;
#pragma unroll
            for (int ai = 0; ai < 2; ++ai)
#pragma unroll
                for (int m = 0; m < 4; ++m) {
                    const int row = row0 + ai * HALF + m * 16;
                    f32x4 x0 = acc[ai][bj][m][0] * QSCALE, x1 = acc[ai][bj][m][1] * QSCALE;
                    if (pe) {
                        const int t = (row - MCTX) & 1023; const int fo = t * 32 + (sub - 4) * 16 + 4 * fq;
                        const f32x4 c = *(const f32x4*)(rc + fo), s = *(const f32x4*)(rs + fo);
                        const f32x4 y0 = x0 * c - x1 * s, y1 = x1 * c + x0 * s; x0 = y0; x1 = y1;
                    }
                    u32x2 w0, w1; w0.x = cvt_pk_bf16(x0[0], x0[1]); w0.y = cvt_pk_bf16(x0[2], x0[3]); w1.x = cvt_pk_bf16(x1[0], x1[1]); w1.y = cvt_pk_bf16(x1[2], x1[3]);
                    const auto s0 = __builtin_amdgcn_permlane16_swap(w0.x, w1.x, false, false), s1 = __builtin_amdgcn_permlane16_swap(w0.y, w1.y, false, false);
                    u32x4 w; w.x = s0[0]; w.y = s1[0]; w.z = s0[1]; w.w = s1[1];
                    bf16_t* p = Q + (size_t)row * NQ + (colb & ~7) + ((fq & 1) ? 16 : 0);
                    *(u32x4*)p = w;
                }
        }
    }
};

template <class Epi, class Sched, bool ALIGN_EPI = false, bool SP2 = false, int MB = 4>
__device__ __forceinline__ void gemm_phase(LAS unsigned char* lds, const Gemm g, const Sched& S, const Epi& E) {
    const int tid = threadIdx.x, wid = __builtin_amdgcn_readfirstlane(tid >> 6), lane = tid & 63, wr = wid >> 2, wc = wid & 3, fr = lane & 15, fq = lane >> 4;
    const int K = g.K, nt = K / BK;
    unsigned voffA[2], voffB[2];
#pragma unroll
    for (int i = 0; i < 2; ++i) { int R, C; stage_rc(tid * 16 + i * 8192, R, C); const int Rb = Epi::PERM ? ((R & ~31) + perm32(R & 31)) : R;
        voffA[i] = (unsigned)(R * K + C) * 2u; voffB[i] = (unsigned)(Rb * K + C) * 2u; }
    const size_t kstep = (size_t)(BK * 2);
    const size_t hstep = (size_t)HALF * K * 2;
    const size_t tstep = 2 * hstep;
    const size_t hstepA = (size_t)(32 * MB) * K * 2;
    const size_t tstepA = 2 * hstepA;
    const unsigned ldsw = (unsigned)wid * 1024u;
    const int aoff = lds_byte(wr * 16 * MB + fr, fq * 8), boff = lds_byte(wc * 32 + fr, fq * 8);
    const bool a2nd = (MB == 4) || (MB == 3 && wr == 0);
#define PG8_SA(b, h) (((b) * 2 + (h)) * HTB)
#define PG8_SB(b, h) ((4 + (b) * 2 + (h)) * HTB)
#define PG8_STAGE(bufoff, gbase, voff) do { _Pragma("unroll") for (int _i = 0; _i < 2; ++_i) \
        __builtin_amdgcn_global_load_lds((const unsigned*)((const char*)(gbase) + (voff)[_i]), (LAS unsigned*)(lds + (bufoff) + ldsw + _i * 8192), 16, 0, 0); } while (0)
#define PG8_STAGEA(bufoff, gbase, voff) do { \
        __builtin_amdgcn_global_load_lds((const unsigned*)((const char*)(gbase) + (voff)[0]), (LAS unsigned*)(lds + (bufoff) + ldsw), 16, 0, 0); \
        if (a2nd) __builtin_amdgcn_global_load_lds((const unsigned*)((const char*)(gbase) + (voff)[1]), (LAS unsigned*)(lds + (bufoff) + ldsw + 8192), 16, 0, 0); } while (0)
#define PG8_WAIT_VA(n4, n3) do { if (!a2nd) asm volatile("s_waitcnt vmcnt(" #n3 ")" ::: "memory"); else asm volatile("s_waitcnt vmcnt(" #n4 ")" ::: "memory"); } while (0)
#define PG8_LDA(dst, b, h) do { _Pragma("unroll") for (int m = 0; m < MB; ++m) _Pragma("unroll") for (int k = 0; k < 2; ++k) dst[m][k] = *(const LAS bf16x8*)(lds + PG8_SA(b, h) + aoff + m * 2048 + k * 1024); } while (0)
#define PG8_LDB(dst, b, h) do { _Pragma("unroll") for (int n = 0; n < 2; ++n) _Pragma("unroll") for (int k = 0; k < 2; ++k) dst[n][k] = *(const LAS bf16x8*)(lds + PG8_SB(b, h) + boff + n * 2048 + k * 1024); } while (0)
#define PG8_MMA(ai, bj, At, Bt) do { __builtin_amdgcn_s_setprio(1); _Pragma("unroll") for (int m = 0; m < MB; ++m) _Pragma("unroll") for (int n = 0; n < 2; ++n) _Pragma("unroll") for (int k = 0; k < 2; ++k) \
        acc[ai][bj][m][n] = __builtin_amdgcn_mfma_f32_16x16x32_bf16(Bt[n][k], At[m][k], acc[ai][bj][m][n], 0, 0, 0); __builtin_amdgcn_s_setprio(0); } while (0)
#define PG8_WAIT_V(n) asm volatile("s_waitcnt vmcnt(" #n ")" ::: "memory")
#define PG8_WAIT_L(n) asm volatile("s_waitcnt lgkmcnt(" #n ")" ::: "memory")
#define PG8_BAR __builtin_amdgcn_s_barrier()
#define PG8_SCHED __builtin_amdgcn_sched_barrier(0)
    Unit cur, nxt; int ui = 0;
    if (!S.next(0, cur)) return;
    f32x4 acc[2][2][MB][2];
#pragma unroll
    for (int a = 0; a < 2; ++a)
#pragma unroll
        for (int b = 0; b < 2; ++b)
#pragma unroll
            for (int m = 0; m < MB; ++m)
#pragma unroll
                for (int n = 0; n < 2; ++n) acc[a][b][m][n] = (f32x4){0.f, 0.f, 0.f, 0.f};
    bf16x8 At[MB][2], B0[2][2], B1[2][2];
    const char* cA = (const char*)g.A + (size_t)cur.pm * tstepA; const char* cB = (const char*)g.Bt + (size_t)cur.pn * tstep;
    S.a_ready(cur);
    if constexpr (SP2) {
        PG8_STAGE(PG8_SB(0, 0), cB, voffB); PG8_STAGE(PG8_SB(0, 1), cB + hstep, voffB); PG8_STAGEA(PG8_SA(0, 0), cA, voffA); PG8_STAGEA(PG8_SA(0, 1), cA + hstepA, voffA);
        if (wr == 1) PG8_BAR;
        PG8_WAIT_VA(2, 1); PG8_BAR;
        PG8_STAGE(PG8_SB(1, 0), cB + kstep, voffB); PG8_STAGEA(PG8_SA(1, 0), cA + kstep, voffA); PG8_STAGE(PG8_SB(1, 1), cB + hstep + kstep, voffB);
        PG8_WAIT_VA(6, 5); PG8_BAR;
    } else {
        PG8_STAGE(PG8_SB(0, 0), cB, voffB); PG8_STAGEA(PG8_SA(0, 0), cA, voffA); PG8_STAGE(PG8_SB(0, 1), cB + hstep, voffB); PG8_STAGEA(PG8_SA(0, 1), cA + hstepA, voffA);
        if (wr == 1) PG8_BAR;
        PG8_WAIT_V(4); PG8_BAR;
        PG8_STAGE(PG8_SB(1, 0), cB + kstep, voffB); PG8_STAGEA(PG8_SA(1, 0), cA + kstep, voffA); PG8_STAGE(PG8_SB(1, 1), cB + hstep + kstep, voffB);
        PG8_WAIT_V(6); PG8_BAR;
    }
    for (;;) {
        const bool has_next = S.next(ui + 1, nxt);
        const char* nA = has_next ? (const char*)g.A + (size_t)nxt.pm * tstepA : cA; const char* nB = has_next ? (const char*)g.Bt + (size_t)nxt.pn * tstep : cB;
        for (int t = 0; t < nt; t += 2) {
            const bool last = (t == nt - 2);
            const char* a1 = cA + (size_t)(t + 1) * kstep;
            const char* a2 = last ? nA : cA + (size_t)(t + 2) * kstep; const char* b2 = last ? nB : cB + (size_t)(t + 2) * kstep;
            const char* a3 = a2 + kstep; const char* b3 = b2 + kstep;
            if (last && has_next) S.a_ready(nxt);
            if constexpr (SP2) {
            PG8_LDB(B0, 0, 0); PG8_LDB(B1, 0, 1); PG8_SCHED; PG8_LDA(At, 0, 0); PG8_STAGEA(PG8_SA(1, 1), a1 + hstepA, voffA);
            PG8_WAIT_VA(8, 6); PG8_WAIT_L(0); PG8_BAR; PG8_MMA(0, 0, At, B0); PG8_MMA(0, 1, At, B1); PG8_BAR; PG8_SCHED;
            PG8_LDA(At, 0, 1); PG8_STAGE(PG8_SB(0, 0), b2, voffB); PG8_STAGE(PG8_SB(0, 1), b2 + hstep, voffB); PG8_STAGEA(PG8_SA(0, 0), a2, voffA);
            PG8_WAIT_VA(8, 6); PG8_WAIT_L(0); PG8_BAR; PG8_MMA(1, 0, At, B0); PG8_MMA(1, 1, At, B1); PG8_BAR; PG8_SCHED;
            PG8_LDB(B0, 1, 0); PG8_LDB(B1, 1, 1); PG8_SCHED; PG8_LDA(At, 1, 0); PG8_STAGEA(PG8_SA(0, 1), a2 + hstepA, voffA);
            PG8_WAIT_VA(8, 6); PG8_WAIT_L(0); PG8_BAR; PG8_MMA(0, 0, At, B0); PG8_MMA(0, 1, At, B1); PG8_BAR; PG8_SCHED;
            PG8_LDA(At, 1, 1); PG8_STAGE(PG8_SB(1, 0), b3, voffB); PG8_STAGE(PG8_SB(1, 1), b3 + hstep, voffB); PG8_STAGEA(PG8_SA(1, 0), a3, voffA);
            PG8_WAIT_VA(8, 6); PG8_WAIT_L(0); PG8_BAR; PG8_MMA(1, 0, At, B0); PG8_MMA(1, 1, At, B1); PG8_BAR; PG8_SCHED;
            } else {
            PG8_LDB(B0, 0, 0); PG8_SCHED; PG8_LDA(At, 0, 0); PG8_STAGEA(PG8_SA(1, 1), a1 + hstepA, voffA);
            PG8_WAIT_L(8); PG8_BAR; PG8_WAIT_L(0); PG8_MMA(0, 0, At, B0); PG8_BAR; PG8_SCHED;
            PG8_LDB(B1, 0, 1); PG8_STAGE(PG8_SB(0, 0), b2, voffB);
            PG8_BAR; PG8_WAIT_L(0); PG8_MMA(0, 1, At, B1); PG8_BAR;
            PG8_LDA(At, 0, 1); PG8_STAGEA(PG8_SA(0, 0), a2, voffA);
            PG8_BAR; PG8_WAIT_L(0); PG8_MMA(1, 0, At, B0); PG8_BAR; PG8_SCHED;
            PG8_STAGE(PG8_SB(0, 1), b2 + hstep, voffB);
            PG8_WAIT_V(6); PG8_BAR; PG8_MMA(1, 1, At, B1); PG8_BAR;
            PG8_LDB(B0, 1, 0); PG8_SCHED; PG8_LDA(At, 1, 0); PG8_STAGEA(PG8_SA(0, 1), a2 + hstepA, voffA);
            PG8_WAIT_L(8); PG8_BAR; PG8_WAIT_L(0); PG8_MMA(0, 0, At, B0); PG8_BAR; PG8_SCHED;
            PG8_LDB(B1, 1, 1); PG8_STAGE(PG8_SB(1, 0), b3, voffB);
            PG8_BAR; PG8_WAIT_L(0); PG8_MMA(0, 1, At, B1); PG8_BAR;
            PG8_LDA(At, 1, 1); PG8_STAGEA(PG8_SA(1, 0), a3, voffA);
            PG8_BAR; PG8_WAIT_L(0); PG8_MMA(1, 0, At, B0); PG8_BAR; PG8_SCHED;
            PG8_STAGE(PG8_SB(1, 1), b3 + hstep, voffB);
            PG8_WAIT_V(6); PG8_BAR; PG8_MMA(1, 1, At, B1); PG8_BAR;
            }
        }
        if constexpr (ALIGN_EPI) { if (wr == 0) PG8_BAR; }
        if constexpr (!Epi::AFTER_DRAIN) { E.template operator()<MB>(acc, cur, wr, wc, fr, fq); S.done(cur); }
        if (!has_next) break;
#pragma unroll
        for (int a = 0; a < 2; ++a)
#pragma unroll
            for (int b = 0; b < 2; ++b)
#pragma unroll
                for (int m = 0; m < MB; ++m)
#pragma unroll
                    for (int n = 0; n < 2; ++n) acc[a][b][m][n] = (f32x4){0.f, 0.f, 0.f, 0.f};
        cur = nxt; cA = nA; cB = nB; ++ui;
        if constexpr (ALIGN_EPI) { if (wr == 1) PG8_BAR; }
    }
    PG8_WAIT_V(0);
    if constexpr (!ALIGN_EPI) { if (wr == 0) PG8_BAR; }
    PG8_BAR;
#undef PG8_SA
#undef PG8_SB
#undef PG8_STAGE
#undef PG8_STAGEA
#undef PG8_WAIT_VA
#undef PG8_LDA
#undef PG8_LDB
#undef PG8_MMA
#undef PG8_WAIT_V
#undef PG8_WAIT_L
#undef PG8_BAR
#undef PG8_SCHED
}
}

#define XB_TMO      128
#define XB_XCNT(j)  (256  + 64 * (j))
#define XB_XSUB(j)  (1280 + 64 * (j))
#define XB_XGEN(j)  (2304 + 64 * (j))
#define XB_TOP      3328
#define XB_TOPGEN   3392
#define XCD_BAR_WORDS 3456
#define XB_SPIN_CAP (1u << 18)
__device__ __forceinline__ unsigned xb_ld(unsigned* p)              { return __hip_atomic_load(p, __ATOMIC_RELAXED, __HIP_MEMORY_SCOPE_AGENT); }
__device__ __forceinline__ unsigned xb_add(unsigned* p, unsigned v) { return __hip_atomic_fetch_add(p, v, __ATOMIC_RELAXED, __HIP_MEMORY_SCOPE_AGENT); }
__device__ __forceinline__ unsigned xb_xcc_id() { return (unsigned)__builtin_amdgcn_s_getreg((3 << 11) | 20) & 0xFu; }
#define XB_SPIN(cond, bar) do { unsigned _sp = 0; while (cond) { __builtin_amdgcn_s_sleep(1); \
    if ((++_sp & 255u) == 0u) { if (xb_ld(&(bar)[XB_TMO])) break; if (_sp > XB_SPIN_CAP) { atomicAdd(&(bar)[XB_TMO], 1u); break; } } } } while (0)
struct XcdBarrier { unsigned* bar; unsigned x; volatile LAS unsigned* st; };
__device__ __forceinline__ XcdBarrier xcd_barrier_post(unsigned* bar, volatile LAS unsigned* st) {
    XcdBarrier b; b.bar = bar; b.x = xb_xcc_id(); b.st = st;
    if (threadIdx.x == 0) (void)xb_add(&bar[XB_XCNT(b.x)], 1u);
    return b;
}
__device__ __forceinline__ void xcd_barrier_complete(unsigned* bar, unsigned x, unsigned& nloc, unsigned& nx) {
    const unsigned G = gridDim.x * gridDim.y * gridDim.z;
    unsigned sum, cnt, mine, sp = 0u;
    for (;;) {
        sum = 0u; cnt = 0u; mine = 0u;
#pragma unroll
        for (unsigned j = 0; j < 16; ++j) { const unsigned c = xb_ld(&bar[XB_XCNT(j)]); sum += c; cnt += (c > 0u) ? 1u : 0u; mine = (j == x) ? c : mine; }
        if (sum == G) break;
        __builtin_amdgcn_s_sleep(1);
        if ((++sp & 255u) == 0u) { if (xb_ld(&bar[XB_TMO])) break; if (sp > XB_SPIN_CAP) { atomicAdd(&bar[XB_TMO], 1u); break; } }
    }
    nloc = mine > 0u ? mine : 1u; nx = cnt > 0u ? cnt : 1u;
}
__device__ __forceinline__ void xcd_barrier(const XcdBarrier& b) {
    asm volatile("s_waitcnt vmcnt(0)" ::: "memory");
    __syncthreads();
    if (threadIdx.x == 0) {
        unsigned* bar = b.bar;
        __builtin_amdgcn_s_waitcnt(0);
        unsigned nloc = b.st[0], nx = b.st[1];
        if (nloc == 0u) { xcd_barrier_complete(bar, b.x, nloc, nx); b.st[0] = nloc; b.st[1] = nx; }
        const unsigned old = xb_add(&bar[XB_XSUB(b.x)], 1u);
        const unsigned gen = old / nloc;
        if (old + 1u == (gen + 1u) * nloc) {
            __builtin_amdgcn_fence(__ATOMIC_RELEASE, "agent");
            asm volatile("s_waitcnt vmcnt(0)" ::: "memory");
            const unsigned og = xb_add(&bar[XB_TOP], 1u);
            const unsigned tg = og / nx;
            if (og + 1u == (tg + 1u) * nx) xb_add(&bar[XB_TOPGEN], 1u);
            else XB_SPIN(xb_ld(&bar[XB_TOPGEN]) == tg, bar);
            __builtin_amdgcn_fence(__ATOMIC_ACQUIRE, "agent");
            xb_add(&bar[XB_XGEN(b.x)], 1u);
            asm volatile("s_waitcnt vmcnt(0)" ::: "memory");
        } else {
            XB_SPIN(xb_ld(&bar[XB_XGEN(b.x)]) == gen, bar);
            __builtin_amdgcn_fence(__ATOMIC_ACQUIRE, "agent");
            asm volatile("s_waitcnt vmcnt(0)" ::: "memory");
        }
    }
    __syncthreads();
}

struct Args { const float* in[30]; float* out; unsigned char* ws; int ph_lo, ph_hi, use_bar, pad; };
struct Frame {
    LAS unsigned char* lds;
    int tid, lane, wave, vcu, G;
};
typedef const __attribute__((address_space(4))) Args* KA;
__device__ __forceinline__ KA get_ka() { KA p = (KA)__builtin_amdgcn_kernarg_segment_ptr(); asm volatile("" : "+s"(p)); return p; }
#define IN_(i) (ka->in[i])
#define WS_ (ka->ws)
#define OUT_ (ka->out)
#define MODS_ ((float*)(ka->ws + WS_MODS))
#define ROPEC_ ((float*)(ka->ws + WS_ROPE))
#define ROPES_ ((float*)(ka->ws + WS_ROPE) + 1024 * 32)
enum { I_XP = 0, I_XS, I_CCKV, I_CKPE, I_SRE, I_SIM, I_C, I_CCTX, I_MODW, I_MODB, I_NORMG, I_WIN, I_WOUT, I_WDQ, I_QNORM, I_WUQ, I_WDKV, I_KVNORM, I_WUKV, I_WO,
       I_ARE, I_AIM, I_LOGDT, I_BRE, I_BIM, I_CRE, I_CIM, I_S5D, I_WGLU, I_FING };

__device__ __forceinline__ void tr_item(const float* W, int K, int N, bf16_t* WT, int k0, int n0, LAS float* scr, int lane) {
    const int lr = lane >> 4, lc = lane & 15;
    f32x4 v[16];
#pragma unroll
    for (int i = 0; i < 16; ++i) v[i] = __builtin_nontemporal_load((const f32x4*)(W + (size_t)(k0 + 4 * i + lr) * N + n0 + 4 * lc));
#pragma unroll
    for (int i = 0; i < 16; ++i) { const int k = 4 * i + lr; *(LAS f32x4*)(scr + k * 64 + ((4 * lc) ^ (4 * ((k >> 3) & 7)))) = v[i]; }
    asm volatile("s_waitcnt lgkmcnt(0)" ::: "memory");
    const int c = lane & 7;
#pragma unroll
    for (int j = 0; j < 8; ++j) {
        const int n = (lane >> 3) + 8 * j; const LAS float* s = scr + (8 * c) * 64 + (n ^ (4 * c));
        u32x4 o; o.x = cvt_pk_bf16(s[0 * 64], s[1 * 64]); o.y = cvt_pk_bf16(s[2 * 64], s[3 * 64]); o.z = cvt_pk_bf16(s[4 * 64], s[5 * 64]); o.w = cvt_pk_bf16(s[6 * 64], s[7 * 64]);
        *(u32x4*)(WT + (size_t)n * K + k0 + 8 * c) = o;
    }
    asm volatile("s_waitcnt lgkmcnt(0)" ::: "memory");
}
__device__ __forceinline__ int ilv_row(int n, int Hh) { const int hi = n >= Hh ? 1 : 0; const int c = n - hi * Hh; return 256 * (c >> 7) + 128 * hi + (c & 127); }

__device__ __forceinline__ int conv_items(int m) {
    return m < 4 ? 32 * 176 : m < 8 ? 88 * 32 : m == 8 ? 32 * 12 : m == 9 ? 32 * 9 : m == 10 ? 12 * 48 : m == 11 ? 8 * 64 : m == 12 ? 32 * 32 : 32 * 64;
}
__device__ __forceinline__ void conv_item(KA ka, int m, int r, LAS float* scr, int lane) {
    if (m < 4) { const int kb = r / 176, nb = r % 176;
        tr_item(IN_(I_WIN) + (size_t)m * D * NFF2, D, NFF2, (bf16_t*)(WS_ + WS_WIN) + (size_t)m * NFF2 * D + (size_t)ilv_row(64 * nb, DFF) * D, 64 * kb, 64 * nb, scr, lane); }
    else if (m < 8) { const int mi = m - 4, kb = r / 32, nb = r % 32;
        tr_item(IN_(I_WOUT) + (size_t)mi * DFF * D, DFF, D, (bf16_t*)(WS_ + WS_WOUT) + (size_t)mi * D * DFF + (size_t)(64 * nb) * DFF, 64 * kb, 64 * nb, scr, lane); }
    else if (m == 8) { const int kb = r / 12, nb = r % 12;
        tr_item(IN_(I_WDQ), D, QL, (bf16_t*)(WS_ + WS_WA) + (size_t)(64 * nb) * D, 64 * kb, 64 * nb, scr, lane); }
    else if (m == 9) { const int kb = r / 9, nb = r % 9;
        tr_item(IN_(I_WDKV), D, 576, (bf16_t*)(WS_ + WS_WA) + (size_t)(QL + 64 * nb) * D, 64 * kb, 64 * nb, scr, lane); }
    else if (m == 10) { const int kb = r / 48, nb = r % 48;
        tr_item(IN_(I_WUQ), QL, NQ, (bf16_t*)(WS_ + WS_WUQ) + (size_t)(64 * nb) * QL, 64 * kb, 64 * nb, scr, lane); }
    else if (m == 11) { const int kb = r / 64, nb = r % 64; const int n0 = 64 * nb, hh = n0 >> 8, j = n0 & 255; const int drow = (j < 128 ? 0 : 2048) + hh * 128 + (j & 127);
        tr_item(IN_(I_WUKV), KVL, 4096, (bf16_t*)(WS_ + WS_WUK) + (size_t)drow * KVL, 64 * kb, n0, scr, lane); }
    else if (m == 12) { const int kb = r / 32, nb = r % 32;
        tr_item(IN_(I_WO), D, D, (bf16_t*)(WS_ + WS_WO) + (size_t)(64 * nb) * D, 64 * kb, 64 * nb, scr, lane); }
    else { const int kb = r / 64, nb = r % 64;
        tr_item(IN_(I_WGLU), D, 4096, (bf16_t*)(WS_ + WS_WGLU) + (size_t)ilv_row(64 * nb, D) * D, 64 * kb, 64 * nb, scr, lane); }
}
constexpr int WIN1_SPLIT = 1792;
__device__ __forceinline__ unsigned conv_slot_mask(int slot) {
    return slot == 0 ? (1u << 0)
         : slot == 1 ? ((1u << 4) | (1u << 8) | (1u << 9) | (1u << 10) | (1u << 11) | (1u << 12) | (1u << 1))
         : slot == 2 ? (1u << 1)
         : slot == 3 ? ((1u << 5) | (1u << 2))
         : slot == 6 ? (1u << 13)
         : slot == 4 ? ((1u << 6) | (1u << 3))
         : (1u << 7);
}
__device__ __forceinline__ void convert_slot(Frame& F, KA ka, int slot, int worker, int nworkers) {
    LAS float* scr = (LAS float*)(F.lds + F.wave * 16384);
    const unsigned mask = conv_slot_mask(slot);
    int base = 0;
#pragma unroll 1
    for (int m = 0; m < 14; ++m) {
        if (!((mask >> m) & 1u)) continue;
        int lo = 0, hi = conv_items(m);
        if (m == 1) { if (slot == 1) hi = WIN1_SPLIT; else lo = WIN1_SPLIT; }
        const int n = hi - lo;
        int it = worker - (base % nworkers); if (it < 0) it += nworkers;
        for (; it < n; it += nworkers) conv_item(ka, m, lo + it, scr, F.lane);
        base += n;
    }
}
__device__ __forceinline__ void phase_prologue(Frame& F) {
    KA ka = get_ka();
    const int tid = F.tid;
    for (int i = blockIdx.x * 512 + tid; i < 1024 * 32; i += F.G * 512) {
        const int t = i >> 5, f = i & 31; const int pos = (f < 16) ? (t >> 6) : (t & 63);
        const float inv = exp2f(-(float)(f & 15) * (13.287712379549449f / 16.0f));
        const float ang = (float)pos * inv;
        ROPEC_[i] = cosf(ang); ROPES_[i] = sinf(ang);
    }
    {
        bf16_t* ckv = (bf16_t*)(WS_ + WS_CKV); bf16_t* kpe = (bf16_t*)(WS_ + WS_KPE);
        for (int i = blockIdx.x * 512 + tid; i < 2 * 256 * 128; i += F.G * 512) {
            const int row = i >> 7, c4 = i & 127, b = row >> 8, s = row & 255;
            const f32x4 v = *(const f32x4*)(IN_(I_CCKV) + (size_t)row * 512 + 4 * c4);
            u32x2 w; w.x = cvt_pk_bf16(v[0], v[1]); w.y = cvt_pk_bf16(v[2], v[3]);
            *(u32x2*)(ckv + (size_t)(MCTX + b * 1280 + s) * 512 + 4 * c4) = w;
        }
        for (int i = blockIdx.x * 512 + tid; i < 2 * 256 * 16; i += F.G * 512) {
            const int row = i >> 4, c4 = i & 15, b = row >> 8, s = row & 255;
            const f32x4 v = *(const f32x4*)(IN_(I_CKPE) + (size_t)row * 64 + 4 * c4);
            u32x2 w; w.x = cvt_pk_bf16(v[0], v[1]); w.y = cvt_pk_bf16(v[2], v[3]);
            *(u32x2*)(kpe + (size_t)(MCTX + b * 1280 + s) * 64 + 4 * c4) = w;
        }
    }
    {
        LAS float* sc = (LAS float*)F.lds;
        LAS float* red = sc + 3 * 2048;
        for (int i = tid; i < 3 * 2048; i += 512) { const int s = i >> 11, k = i & 2047; const float v = (s == 0) ? IN_(I_CCTX)[k] : IN_(I_C)[(s - 1) * 2048 + k]; sc[i] = v / (1.0f + expf(-v)); }
        __syncthreads();
        const int c4 = tid & 31, kg = tid >> 5;
        for (int tile = blockIdx.x; tile < 288; tile += F.G) {
            const int l = tile / 144, n0 = (tile % 144) * 128;
            const float* wp = IN_(I_MODW) + ((size_t)l * 2048 + kg * 128) * NMOD + n0 + 4 * c4;
            f32x4 a0 = {0.f, 0.f, 0.f, 0.f}, a1 = a0, a2 = a0;
#pragma unroll 8
            for (int j = 0; j < 128; ++j) {
                const f32x4 w = __builtin_nontemporal_load((const f32x4*)(wp + (size_t)j * NMOD));
                const int k = kg * 128 + j; a0 += w * sc[k]; a1 += w * sc[2048 + k]; a2 += w * sc[4096 + k];
            }
#pragma unroll
            for (int i = 0; i < 4; ++i) { red[(kg * 3 + 0) * 128 + 4 * c4 + i] = a0[i]; red[(kg * 3 + 1) * 128 + 4 * c4 + i] = a1[i]; red[(kg * 3 + 2) * 128 + 4 * c4 + i] = a2[i]; }
            __syncthreads();
            if (tid < 384) {
                const int s = tid >> 7, n = tid & 127; float sum = 0.f;
#pragma unroll 8
                for (int g = 0; g < 16; ++g) sum += red[(g * 3 + s) * 128 + n];
                MODS_[(size_t)(l * 3 + s) * NMOD + n0 + n] = sum + IN_(I_MODB)[l * NMOD + n0 + n];
            }
            __syncthreads();
        }
    }
    __syncthreads();
    {
        LAS float* scr = (LAS float*)(F.lds + F.wave * 16384);
        if ((int)blockIdx.x >= 32) { const int nb2 = F.G - 32; for (int it = ((int)blockIdx.x - 32) * 8 + F.wave; it < 5632; it += nb2 * 8) conv_item(ka, 0, it, scr, F.lane); }
    }
}

__device__ __forceinline__ void phase_norm(Frame& F, int l, int sub, bool first_sub) {
    KA ka = get_ka();
    const float* xa = IN_(I_XP); const float* xb = IN_(I_XS) - (size_t)MCTX * D; const bf16_t* X = (const bf16_t*)(WS_ + WS_X);
    const int gw = F.vcu * 8 + F.wave, NGW = F.G * 8, lane = F.lane;
    bf16_t* H = (bf16_t*)(WS_ + WS_H);
    const float* gp = IN_(I_NORMG) + (size_t)(l * 3 + sub) * D;
    for (int chunk = gw; chunk < MT / 3; chunk += NGW) {
        f32x4 vf[3][8]; u32x2 vh[3][8];
#pragma unroll
        for (int r = 0; r < 3; ++r) {
            const int row = 3 * chunk + r; const float* xr = (row < MCTX ? xa : xb) + (size_t)row * D;
#pragma unroll
            for (int j = 0; j < 8; ++j) { if (first_sub) vf[r][j] = *(const f32x4*)(xr + 4 * lane + 256 * j); else vh[r][j] = *(const u32x2*)(X + (size_t)row * D + 4 * lane + 256 * j); }
        }
        int ms_have = -1; f32x4 gs[8], sh[8];
#pragma unroll
        for (int r = 0; r < 3; ++r) {
            const int row = 3 * chunk + r;
            const int ms = row < MCTX ? 0 : 1 + ((row - MCTX) >> 10);
            if (ms != ms_have) {
                const float* mv = MODS_ + (size_t)(l * 3 + ms) * NMOD + sub * 3 * D;
#pragma unroll
                for (int j = 0; j < 8; ++j) { const int idx = 4 * lane + 256 * j; gs[j] = *(const f32x4*)(gp + idx) * (*(const f32x4*)(mv + D + idx) + 1.0f); sh[j] = *(const f32x4*)(mv + idx); }
                ms_have = ms;
            }
            f32x4 v[8]; float ss = 0.f;
#pragma unroll
            for (int j = 0; j < 8; ++j) { v[j] = first_sub ? vf[r][j] : pg8::bf4_f4(vh[r][j]); ss += (v[j][0] * v[j][0] + v[j][1] * v[j][1]) + (v[j][2] * v[j][2] + v[j][3] * v[j][3]); }
            ss = wave_sum(ss);
            const float rstd = 1.0f / sqrtf(ss * (1.0f / D) + EPS);
#pragma unroll
            for (int j = 0; j < 8; ++j) {
                const f32x4 o = v[j] * rstd * gs[j] + sh[j];
                u32x2 w; w.x = cvt_pk_bf16(o[0], o[1]); w.y = cvt_pk_bf16(o[2], o[3]);
                *(u32x2*)(H + (size_t)row * D + 4 * lane + 256 * j) = w;
            }
        }
    }
}
__device__ __forceinline__ void phase_final(Frame& F) {
    KA ka = get_ka();
    const int gw = F.vcu * 8 + F.wave, NGW = F.G * 8, lane = F.lane;
    const bf16_t* X = (const bf16_t*)(WS_ + WS_X); const float* gp = IN_(I_FING);
    f32x4 gq[8];
#pragma unroll
    for (int j = 0; j < 8; ++j) gq[j] = *(const f32x4*)(gp + 4 * lane + 256 * j);
    for (int row0 = gw; row0 < MT; row0 += 3 * NGW) {
        u32x2 vh[3][8];
#pragma unroll
        for (int r = 0; r < 3; ++r) { const int row = row0 + r * NGW; const bf16_t* xr = X + (size_t)(row < MT ? row : row0) * D;
#pragma unroll
            for (int j = 0; j < 8; ++j) vh[r][j] = *(const u32x2*)(xr + 4 * lane + 256 * j); }
#pragma unroll
        for (int r = 0; r < 3; ++r) {
            const int row = row0 + r * NGW; if (row >= MT) break;
            f32x4 v[8]; float ss = 0.f;
#pragma unroll
            for (int j = 0; j < 8; ++j) { v[j] = pg8::bf4_f4(vh[r][j]); ss += (v[j][0] * v[j][0] + v[j][1] * v[j][1]) + (v[j][2] * v[j][2] + v[j][3] * v[j][3]); }
            ss = wave_sum(ss);
            const float rstd = 1.0f / sqrtf(ss * (1.0f / D) + EPS);
#pragma unroll
            for (int j = 0; j < 8; ++j) { const int idx = 4 * lane + 256 * j; __builtin_nontemporal_store(v[j] * rstd * gq[j], (f32x4*)(OUT_ + OUT_Y + (size_t)row * D + idx)); }
        }
    }
}
__device__ __forceinline__ void phase_mla_norm(Frame& F) {
    KA ka = get_ka();
    const int gw = F.vcu * 8 + F.wave, NGW = F.G * 8, lane = F.lane;
    const bf16_t* C = (const bf16_t*)(WS_ + WS_CQKV);
    bf16_t* CQ = (bf16_t*)(WS_ + WS_CQ); bf16_t* CKV = (bf16_t*)(WS_ + WS_CKV); bf16_t* KPE = (bf16_t*)(WS_ + WS_KPE);
    const float* qn = IN_(I_QNORM); const float* kn = IN_(I_KVNORM);
    f32x4 qg[3], kg[2];
#pragma unroll
    for (int j = 0; j < 3; ++j) qg[j] = *(const f32x4*)(qn + 4 * lane + 256 * j);
#pragma unroll
    for (int j = 0; j < 2; ++j) kg[j] = *(const f32x4*)(kn + 4 * lane + 256 * j);
    for (int row = gw; row < MT; row += NGW) {
        const bf16_t* cr = C + (size_t)row * NA;
        const bool lat = row >= MCTX; const int lb = (row - MCTX) >> 10, t = (row - MCTX) & 1023;
        const int drow = lat ? (MCTX + lb * 1280 + 256 + t) : row;
        f32x4 a[3]; float ss = 0.f;
#pragma unroll
        for (int j = 0; j < 3; ++j) { a[j] = pg8::bf4_f4(*(const u32x2*)(cr + 4 * lane + 256 * j)); ss += (a[j][0] * a[j][0] + a[j][1] * a[j][1]) + (a[j][2] * a[j][2] + a[j][3] * a[j][3]); }
        ss = wave_sum(ss);
        float rstd = 1.0f / sqrtf(ss * (1.0f / QL) + EPS);
#pragma unroll
        for (int j = 0; j < 3; ++j) { const int idx = 4 * lane + 256 * j; const f32x4 o = a[j] * rstd * qg[j];
            u32x2 w; w.x = cvt_pk_bf16(o[0], o[1]); w.y = cvt_pk_bf16(o[2], o[3]); *(u32x2*)(CQ + (size_t)row * QL + idx) = w; }
        f32x4 b[2]; ss = 0.f;
#pragma unroll
        for (int j = 0; j < 2; ++j) { b[j] = pg8::bf4_f4(*(const u32x2*)(cr + QL + 4 * lane + 256 * j)); ss += (b[j][0] * b[j][0] + b[j][1] * b[j][1]) + (b[j][2] * b[j][2] + b[j][3] * b[j][3]); }
        ss = wave_sum(ss);
        rstd = 1.0f / sqrtf(ss * (1.0f / KVL) + EPS);
#pragma unroll
        for (int j = 0; j < 2; ++j) { const int idx = 4 * lane + 256 * j; const f32x4 o = b[j] * rstd * kg[j];
            u32x2 w; w.x = cvt_pk_bf16(o[0], o[1]); w.y = cvt_pk_bf16(o[2], o[3]); *(u32x2*)(CKV + (size_t)drow * KVL + idx) = w;
            if (!lat) *(f32x4*)(OUT_ + OUT_CKV + (size_t)row * KVL + idx) = o; }
        float kv = __uint_as_float((unsigned)(*(const unsigned short*)(cr + QL + KVL + lane)) << 16);
        if (!lat) OUT_[OUT_KPE + (size_t)row * 64 + lane] = kv;
        const float partner = __shfl_xor(kv, 16);
        if (lat) {
            const int f = (lane & 15) + 16 * (lane >> 5);
            const float c = ROPEC_[t * 32 + f], s = ROPES_[t * 32 + f];
            const float rot = (lane & 16) ? partner : -partner;
            kv = kv * c + rot * s;
        }
        const float nb = __shfl_down(kv, 1);
        if ((lane & 1) == 0) *(unsigned*)(KPE + (size_t)drow * 64 + lane) = cvt_pk_bf16(kv, nb);
    }
}

constexpr int AT_KROW = 416, AT_VROW = 160, AT_KT = 64 * AT_KROW, AT_VT = 128 * AT_VROW, AT_STAGE = AT_KT + AT_VT;
__device__ __forceinline__ float xg_max(float v) {
    auto a = __builtin_amdgcn_permlane16_swap(__float_as_uint(v), __float_as_uint(v), false, false);
    v = fmaxf(__uint_as_float(a[0]), __uint_as_float(a[1]));
    auto b = __builtin_amdgcn_permlane32_swap(__float_as_uint(v), __float_as_uint(v), false, false);
    return fmaxf(__uint_as_float(b[0]), __uint_as_float(b[1]));
}
__device__ __forceinline__ float xg_sum(float v) {
    auto a = __builtin_amdgcn_permlane16_swap(__float_as_uint(v), __float_as_uint(v), false, false);
    v = __uint_as_float(a[0]) + __uint_as_float(a[1]);
    auto b = __builtin_amdgcn_permlane32_swap(__float_as_uint(v), __float_as_uint(v), false, false);
    return __uint_as_float(b[0]) + __uint_as_float(b[1]);
}
__device__ __forceinline__ void phase_attn(Frame& F) {
    KA ka = get_ka();
    const int tid = F.tid, lane = F.lane, wave = F.wave, l15 = lane & 15, g4 = lane >> 4;
    const bf16_t* Q = (const bf16_t*)(WS_ + WS_Q); const bf16_t* KN = (const bf16_t*)(WS_ + WS_KN); const bf16_t* KPE = (const bf16_t*)(WS_ + WS_KPE);
    const bf16_t* VT = (const bf16_t*)(WS_ + WS_VT); bf16_t* O = (bf16_t*)(WS_ + WS_O);
    LAS unsigned char* lds = F.lds;
    for (int unit = F.vcu; unit < 768; unit += F.G) {
        int b, h, qb, qrow0, krow0, nk;
        if (unit < 256) { b = unit >> 7; h = (unit >> 3) & 15; qb = unit & 7; qrow0 = MCTX + b * 1024 + qb * 128; krow0 = MCTX + b * 1280; nk = 1280; }
        else { const int u2 = unit - 256; b = u2 >> 5; h = (u2 >> 1) & 15; qb = u2 & 1; qrow0 = b * 256 + qb * 128; krow0 = b * 256; nk = 256; }
        const int ntile = nk >> 6;
        bf16x8 qf[6];
        { const bf16_t* qp = Q + (size_t)(qrow0 + wave * 16 + l15) * NQ + h * 192 + 8 * g4;
#pragma unroll
          for (int s = 0; s < 6; ++s) qf[s] = *(const bf16x8*)(qp + 32 * s); }
        const bf16_t* ksrc[3]; int kdst[3]; int kstr[3];
#pragma unroll
        for (int i = 0; i < 3; ++i) { const int idx = tid + 512 * i, row = idx / 24, ch = idx % 24;
            const int key = 32 * (row >> 5) + 8 * ((row >> 2) & 3) + 4 * ((row >> 4) & 1) + (row & 3);
            ksrc[i] = (ch < 16) ? KN + (size_t)(krow0 + key) * D + h * 128 + ch * 8 : KPE + (size_t)(krow0 + key) * 64 + (ch - 16) * 8;
            kstr[i] = (ch < 16) ? 64 * D : 64 * 64;
            kdst[i] = row * AT_KROW + ch * 16; }
        const bf16_t* vsrc[2]; int vdst[2];
#pragma unroll
        for (int i = 0; i < 2; ++i) { const int idx = tid + 512 * i, row = idx >> 3, ch = idx & 7;
            vsrc[i] = VT + (size_t)(h * 128 + row) * KVR + krow0 + ch * 8; vdst[i] = AT_KT + row * AT_VROW + ch * 16; }
        u32x4 ka_[3], va_[2], kb_[3], vb_[2];
#define AT_LOAD(KS, VS, t) do { _Pragma("unroll") for (int i = 0; i < 3; ++i) KS[i] = *(const u32x4*)(ksrc[i] + (size_t)(t) * kstr[i]); \
                                _Pragma("unroll") for (int i = 0; i < 2; ++i) VS[i] = *(const u32x4*)(vsrc[i] + (t) * 64); } while (0)
#define AT_STORE(KS, VS, off) do { _Pragma("unroll") for (int i = 0; i < 3; ++i) *(LAS u32x4*)(lds + (off) + kdst[i]) = KS[i]; \
                                   _Pragma("unroll") for (int i = 0; i < 2; ++i) *(LAS u32x4*)(lds + (off) + vdst[i]) = VS[i]; } while (0)
        AT_LOAD(kb_, vb_, 0);
        AT_LOAD(ka_, va_, 1);
        __syncthreads();
        AT_STORE(kb_, vb_, 0);
        __syncthreads();
        f32x4 o[8];
#pragma unroll
        for (int i = 0; i < 8; ++i) o[i] = (f32x4){0.f, 0.f, 0.f, 0.f};
        float m_run = -INFINITY, l_run = 0.f;
#define AT_STEP(cur) do { \
            f32x4 sc[4]; \
            _Pragma("unroll") for (int kb = 0; kb < 4; ++kb) { \
                f32x4 a = {0.f, 0.f, 0.f, 0.f}; \
                const LAS unsigned char* kp = lds + (cur) + (16 * kb + l15) * AT_KROW + g4 * 16; \
                _Pragma("unroll") for (int s = 0; s < 6; ++s) { const bf16x8 kf = *(const LAS bf16x8*)(kp + s * 64); a = __builtin_amdgcn_mfma_f32_16x16x32_bf16(kf, qf[s], a, 0, 0, 0); } \
                sc[kb] = a; } \
            float mx = fmaxf(fmaxf(sc[0][0], sc[0][1]), fmaxf(sc[0][2], sc[0][3])); \
            _Pragma("unroll") for (int kb = 1; kb < 4; ++kb) mx = fmaxf(mx, fmaxf(fmaxf(sc[kb][0], sc[kb][1]), fmaxf(sc[kb][2], sc[kb][3]))); \
            mx = xg_max(mx); \
            const float m_new = fmaxf(m_run, mx); \
            const float alpha = __builtin_amdgcn_exp2f(m_run - m_new); \
            m_run = m_new; \
            float ps = 0.f; \
            _Pragma("unroll") for (int kb = 0; kb < 4; ++kb) _Pragma("unroll") for (int i = 0; i < 4; ++i) { sc[kb][i] = __builtin_amdgcn_exp2f(sc[kb][i] - m_new); ps += sc[kb][i]; } \
            l_run = l_run * alpha + ps; \
            _Pragma("unroll") for (int i = 0; i < 8; ++i) o[i] *= alpha; \
            bf16x8 pf[2]; \
            _Pragma("unroll") for (int kp = 0; kp < 2; ++kp) { \
                u32x4 w; w.x = cvt_pk_bf16(sc[2 * kp][0], sc[2 * kp][1]); w.y = cvt_pk_bf16(sc[2 * kp][2], sc[2 * kp][3]); \
                w.z = cvt_pk_bf16(sc[2 * kp + 1][0], sc[2 * kp + 1][1]); w.w = cvt_pk_bf16(sc[2 * kp + 1][2], sc[2 * kp + 1][3]); \
                pf[kp] = __builtin_bit_cast(bf16x8, w); } \
            _Pragma("unroll") for (int db = 0; db < 8; ++db) { \
                const LAS unsigned char* vp = lds + (cur) + AT_KT + (16 * db + l15) * AT_VROW + g4 * 16; \
                _Pragma("unroll") for (int kp = 0; kp < 2; ++kp) { \
                    const bf16x8 vf = *(const LAS bf16x8*)(vp + kp * 64); \
                    o[db] = __builtin_amdgcn_mfma_f32_16x16x32_bf16(vf, pf[kp], o[db], 0, 0, 0); } } \
        } while (0)
        for (int t = 0; t < ntile; t += 2) {
            if (t + 2 < ntile) AT_LOAD(kb_, vb_, t + 2);
            AT_STEP(0);
            AT_STORE(ka_, va_, AT_STAGE);
            __syncthreads();
            if (t + 3 < ntile) AT_LOAD(ka_, va_, t + 3);
            AT_STEP(AT_STAGE);
            if (t + 2 < ntile) AT_STORE(kb_, vb_, 0);
            __syncthreads();
        }
#undef AT_LOAD
#undef AT_STORE
#undef AT_STEP
        const float inv = 1.0f / xg_sum(l_run);
        bf16_t* op = O + (size_t)(qrow0 + wave * 16 + l15) * D + h * 128 + 4 * g4;
#pragma unroll
        for (int db = 0; db < 8; ++db) { u32x2 w; w.x = cvt_pk_bf16(o[db][0] * inv, o[db][1] * inv); w.y = cvt_pk_bf16(o[db][2] * inv, o[db][3] * inv); *(u32x2*)(op + 16 * db) = w; }
    }
}

constexpr int S5_ROW = 288, S5_SUB = 16 * S5_ROW, S5_WAVE = 2 * S5_SUB + 2048, S5_FIN = 8 * S5_WAVE;
struct S5Consts { bf16x8 bfr[4]; bf16x8 cfr[4]; float ar[2], ai[2]; };
__device__ __forceinline__ void s5_consts(KA ka, int g, int d, int lane, S5Consts& K) {
    const int pl = lane & 31, hh = lane >> 5, l15 = lane & 15, g4 = lane >> 4;
    const float dt = expf(IN_(I_LOGDT)[d * 128 + g]);
#pragma unroll
    for (int s = 0; s < 2; ++s) {
        const int p = pl + 32 * s; const size_t pi = (size_t)(d * 128 + g) * 64 + p;
        const float lr = IN_(I_ARE)[pi], li = IN_(I_AIM)[pi];
        const float er = expf(lr * dt); float sn, cs; sincosf(li * dt, &sn, &cs);
        const float abr = er * cs, abi = er * sn;
        K.ar[s] = abr; K.ai[s] = abi;
        const float nr = abr - 1.0f, ni = abi, den = 1.0f / (lr * lr + li * li);
        const float cr = (nr * lr + ni * li) * den, ci = (ni * lr - nr * li) * den;
        const f32x4 b0 = *(const f32x4*)(IN_(I_BRE) + pi * 16 + 8 * hh), b1 = *(const f32x4*)(IN_(I_BRE) + pi * 16 + 8 * hh + 4);
        const f32x4 c0 = *(const f32x4*)(IN_(I_BIM) + pi * 16 + 8 * hh), c1 = *(const f32x4*)(IN_(I_BIM) + pi * 16 + 8 * hh + 4);
        u32x4 wr_, wi_;
        wr_.x = cvt_pk_bf16(cr * b0[0] - ci * c0[0], cr * b0[1] - ci * c0[1]); wr_.y = cvt_pk_bf16(cr * b0[2] - ci * c0[2], cr * b0[3] - ci * c0[3]);
        wr_.z = cvt_pk_bf16(cr * b1[0] - ci * c1[0], cr * b1[1] - ci * c1[1]); wr_.w = cvt_pk_bf16(cr * b1[2] - ci * c1[2], cr * b1[3] - ci * c1[3]);
        wi_.x = cvt_pk_bf16(cr * c0[0] + ci * b0[0], cr * c0[1] + ci * b0[1]); wi_.y = cvt_pk_bf16(cr * c0[2] + ci * b0[2], cr * c0[3] + ci * b0[3]);
        wi_.z = cvt_pk_bf16(cr * c1[0] + ci * b1[0], cr * c1[1] + ci * b1[1]); wi_.w = cvt_pk_bf16(cr * c1[2] + ci * b1[2], cr * c1[3] + ci * b1[3]);
        K.bfr[s] = __builtin_bit_cast(bf16x8, wr_); K.bfr[2 + s] = __builtin_bit_cast(bf16x8, wi_);
    }
#pragma unroll
    for (int ks = 0; ks < 4; ++ks) {
        const size_t ci = ((size_t)(d * 128 + g) * 16 + l15) * 64 + 16 * ks + 4 * g4;
        const f32x4 cr = *(const f32x4*)(IN_(I_CRE) + ci), cm = *(const f32x4*)(IN_(I_CIM) + ci);
        u32x4 w; w.x = cvt_pk_bf16(cr[0], -cm[0]); w.y = cvt_pk_bf16(cr[1], -cm[1]); w.z = cvt_pk_bf16(cr[2], -cm[2]); w.w = cvt_pk_bf16(cr[3], -cm[3]);
        K.cfr[ks] = __builtin_bit_cast(bf16x8, w);
    }
}
template <int MODE, bool BWD>
__device__ __forceinline__ void s5_pass(KA ka, int lane, int g, int rowb0, int rowb1, int nchunk, const S5Consts& K, bf16x8 dfr, float (&hr)[2], float (&hi)[2], LAS unsigned char* hsb) {
    const int pl = lane & 31, hh = lane >> 5, l15 = lane & 15, g4 = lane >> 4;
    const bf16_t* H = (const bf16_t*)(WS_ + WS_H); float* YS = (float*)(WS_ + WS_YST); bf16_t* G = (bf16_t*)(WS_ + WS_G);
    const int a_sub = (pl >> 2) & 1, a_idx = 4 * (pl >> 3) + (pl & 3);
    const bf16_t* ap = H + (size_t)((a_sub ? rowb1 : rowb0) + a_idx) * D + g * 16 + 8 * hh;
    const int t_first = BWD ? 16 * (nchunk - 1) : 0, t_step = BWD ? -16 : 16;
    bf16x8 a_cur = *(const bf16x8*)(ap + (size_t)t_first * D);
    float xr[2] = {hr[0], hr[1]}, xi[2] = {hi[0], hi[1]};
#pragma unroll 1
    for (int c = 0; c < nchunk; ++c) {
        const int t0 = t_first + c * t_step;
        bf16x8 a_nxt = a_cur;
        if (c + 1 < nchunk) a_nxt = *(const bf16x8*)(ap + (size_t)(t0 + t_step) * D);
        float st[2][4]; bf16x8 ua[2];
        if (MODE == 2) {
#pragma unroll
            for (int sb = 0; sb < 2; ++sb) {
                const int rb = (sb ? rowb1 : rowb0) + t0;
#pragma unroll
                for (int i = 0; i < 4; ++i) st[sb][i] = __hip_atomic_load(YS + ((size_t)g * MT + rb + 4 * g4 + i) * 16 + l15, __ATOMIC_RELAXED, __HIP_MEMORY_SCOPE_AGENT);
                const u32x4 z = {0u, 0u, 0u, 0u};
                ua[sb] = __builtin_bit_cast(bf16x8, z);
                if (g4 < 2) ua[sb] = *(const bf16x8*)(H + (size_t)(rb + l15) * D + g * 16 + 8 * g4);
            }
        }
        const f32x16 z16 = {0.f,0.f,0.f,0.f,0.f,0.f,0.f,0.f,0.f,0.f,0.f,0.f,0.f,0.f,0.f,0.f};
#pragma unroll
        for (int s = 0; s < 2; ++s) {
            const f32x16 br_ = __builtin_amdgcn_mfma_f32_32x32x16_bf16(a_cur, K.bfr[s], z16, 0, 0, 0);
            const f32x16 bi_ = __builtin_amdgcn_mfma_f32_32x32x16_bf16(a_cur, K.bfr[2 + s], z16, 0, 0, 0);
            f32x2 x = {xr[s], xi[s]}; const f32x2 ca = {K.ar[s], K.ar[s]}, cb = {-K.ai[s], K.ai[s]};
            LAS unsigned* hw = (LAS unsigned*)(hsb + hh * S5_SUB) + pl + 32 * s;
#pragma unroll
            for (int ii = 0; ii < 16; ++ii) {
                const int i = BWD ? 15 - ii : ii;
                const f32x2 u = {br_[i], bi_[i]}; const f32x2 xs = {x.y, x.x};
                x = ca * x + (cb * xs + u);
                if (MODE != 0) hw[i * (S5_ROW / 4)] = cvt_pk_bf16(x.x, x.y);
            }
            xr[s] = x.x; xi[s] = x.y;
        }
        if (MODE != 0) {
            asm volatile("s_waitcnt lgkmcnt(0)" ::: "memory");
            f32x4 y[2];
#pragma unroll
            for (int sb = 0; sb < 2; ++sb) {
                f32x4 a = {0.f, 0.f, 0.f, 0.f};
                const LAS unsigned char* hp = hsb + sb * S5_SUB + l15 * S5_ROW + g4 * 16;
#pragma unroll
                for (int ks = 0; ks < 4; ++ks) { const bf16x8 hf = *(const LAS bf16x8*)(hp + ks * 64); a = __builtin_amdgcn_mfma_f32_16x16x32_bf16(hf, K.cfr[ks], a, 0, 0, 0); }
                if (MODE == 2) a = __builtin_amdgcn_mfma_f32_16x16x32_bf16(ua[sb], dfr, a, 0, 0, 0);
                y[sb] = a;
            }
            if (MODE == 1) {
#pragma unroll
                for (int sb = 0; sb < 2; ++sb) { const int rb = (sb ? rowb1 : rowb0) + t0;
#pragma unroll
                    for (int i = 0; i < 4; ++i) YS[((size_t)g * MT + rb + 4 * g4 + i) * 16 + l15] = y[sb][i]; }
            } else {
                LAS float* tl = (LAS float*)(hsb + 2 * S5_SUB);
#pragma unroll
                for (int sb = 0; sb < 2; ++sb)
#pragma unroll
                    for (int i = 0; i < 4; ++i) tl[sb * 256 + (4 * g4 + i) * 16 + l15] = gelu_tanh_f(y[sb][i] + st[sb][i]);
                asm volatile("s_waitcnt lgkmcnt(0)" ::: "memory");
                const int tt = pl >> 1, hf = pl & 1;
                const f32x4 o0 = *(const LAS f32x4*)(tl + hh * 256 + tt * 16 + hf * 8), o1 = *(const LAS f32x4*)(tl + hh * 256 + tt * 16 + hf * 8 + 4);
                u32x4 o; o.x = cvt_pk_bf16(o0[0], o0[1]); o.y = cvt_pk_bf16(o0[2], o0[3]); o.z = cvt_pk_bf16(o1[0], o1[1]); o.w = cvt_pk_bf16(o1[2], o1[3]);
                *(u32x4*)(G + (size_t)((hh ? rowb1 : rowb0) + t0 + tt) * D + g * 16 + 8 * hf) = o;
                asm volatile("s_waitcnt lgkmcnt(0)" ::: "memory");
            }
        }
        a_cur = a_nxt;
    }
    if (MODE == 1) asm volatile("s_waitcnt vmcnt(0)" ::: "memory");
    hr[0] = xr[0]; hr[1] = xr[1]; hi[0] = xi[0]; hi[1] = xi[1];
}
__device__ __forceinline__ bf16x8 s5_dfr(KA ka, int g, int lane) {
    const int l15 = lane & 15, g4 = lane >> 4; const float dk = IN_(I_S5D)[g * 16 + l15];
    u32x4 w;
    w.x = cvt_pk_bf16((8 * g4 + 0 == l15) ? dk : 0.f, (8 * g4 + 1 == l15) ? dk : 0.f); w.y = cvt_pk_bf16((8 * g4 + 2 == l15) ? dk : 0.f, (8 * g4 + 3 == l15) ? dk : 0.f);
    w.z = cvt_pk_bf16((8 * g4 + 4 == l15) ? dk : 0.f, (8 * g4 + 5 == l15) ? dk : 0.f); w.w = cvt_pk_bf16((8 * g4 + 6 == l15) ? dk : 0.f, (8 * g4 + 7 == l15) ? dk : 0.f);
    return __builtin_bit_cast(bf16x8, w);
}
__device__ __forceinline__ void phase_s5(Frame& F) {
    KA ka = get_ka();
    const int lane = F.lane, wave = F.wave, pl = lane & 31, hh = lane >> 5;
    LAS unsigned char* hsb = F.lds + wave * S5_WAVE;
    if (F.vcu < 128) {
        const int g = F.vcu;
        LAS float* fin = (LAS float*)(F.lds + S5_FIN);
        const int rowb0 = MCTX + 128 * wave, rowb1 = MCTX + 1024 + 128 * wave;
        const bf16x8 dfr = s5_dfr(ka, g, lane);
#pragma unroll 1
        for (int d = 0; d < 2; ++d) {
            S5Consts K; s5_consts(ka, g, d, lane, K);
            float hr[2] = {0.f, 0.f}, hi[2] = {0.f, 0.f};
            if (d == 0) s5_pass<0, false>(ka, lane, g, rowb0, rowb1, 8, K, dfr, hr, hi, hsb);
            else s5_pass<0, true>(ka, lane, g, rowb0, rowb1, 8, K, dfr, hr, hi, hsb);
#pragma unroll
            for (int s = 0; s < 2; ++s) { LAS float* fp = fin + (((d * 8 + wave) * 2 + hh) * 64 + pl + 32 * s) * 2; fp[0] = hr[s]; fp[1] = hi[s]; }
        }
        __syncthreads();
#pragma unroll 1
        for (int d = 0; d < 2; ++d) {
            S5Consts K; s5_consts(ka, g, d, lane, K);
            float hr[2], hi[2];
#pragma unroll
            for (int s = 0; s < 2; ++s) {
                float pr = K.ar[s], pi_ = K.ai[s];
#pragma unroll
                for (int q = 0; q < 7; ++q) { const float nr = pr * pr - pi_ * pi_, ni = 2.0f * pr * pi_; pr = nr; pi_ = ni; }
                const size_t si = ((size_t)(hh * 2 + d) * 128 + g) * 64 + pl + 32 * s;
                float cr = IN_(I_SRE)[si], ci = IN_(I_SIM)[si];
#pragma unroll 1
                for (int q = 0; q < 7; ++q) {
                    const int sg = d ? 7 - q : q;
                    const bool take = d ? (sg > wave) : (sg < wave);
                    const LAS float* fp = fin + (((d * 8 + sg) * 2 + hh) * 64 + pl + 32 * s) * 2;
                    const float fr = fp[0], fi = fp[1];
                    const float nr = pr * cr - pi_ * ci + fr, ni = pr * ci + pi_ * cr + fi;
                    if (take) { cr = nr; ci = ni; }
                }
                hr[s] = cr; hi[s] = ci;
            }
            if (d == 0) s5_pass<1, false>(ka, lane, g, rowb0, rowb1, 8, K, dfr, hr, hi, hsb);
            else s5_pass<2, true>(ka, lane, g, rowb0, rowb1, 8, K, dfr, hr, hi, hsb);
        }
        __syncthreads();
        convert_slot(F, ka, 6, F.vcu * 8 + wave, 128 * 8);
    } else {
#pragma unroll 1
        for (int item = (F.vcu - 128) * 8 + wave; item < 1024; item += (F.G - 128) * 8) {
            const int g = item >> 3, pr_ = item & 7;
            const int rowb0 = (2 * pr_) * 256, rowb1 = (2 * pr_ + 1) * 256;
            const bf16x8 dfr = s5_dfr(ka, g, lane);
#pragma unroll 1
            for (int d = 0; d < 2; ++d) {
                S5Consts K; s5_consts(ka, g, d, lane, K);
                float hr[2] = {0.f, 0.f}, hi[2] = {0.f, 0.f};
                if (d == 0) s5_pass<1, false>(ka, lane, g, rowb0, rowb1, 16, K, dfr, hr, hi, hsb);
                else s5_pass<2, true>(ka, lane, g, rowb0, rowb1, 16, K, dfr, hr, hi, hsb);
#pragma unroll
                for (int s = 0; s < 2; ++s) { const size_t si = ((size_t)((2 * pr_ + hh) * 2 + d) * 128 + g) * 64 + pl + 32 * s; OUT_[OUT_SRE + si] = hr[s]; OUT_[OUT_SIM + si] = hi[s]; }
            }
        }
    }
}

constexpr int NPH = 23;

__device__ __forceinline__ void gemm_ffn_in(Frame& F, int fi) {
    KA ka = get_ka();
    pg8::Gemm g{(const bf16_t*)(WS_ + WS_H), (const bf16_t*)(WS_ + WS_WIN) + (size_t)fi * NFF2 * D, MT, NFF2, D};
#ifndef G1_MB
#define G1_MB 4
#endif
    pg8::EpiSwiGLU E{(bf16_t*)(WS_ + WS_ACT)};
    if (fi == 3) {
        pg8::Ffn3MainOrder S1{F.G, (int)blockIdx.x};
        pg8::gemm_phase<pg8::EpiSwiGLU, pg8::Ffn3MainOrder, true, true, 3>(F.lds, g, S1, E);
        if (F.vcu < 192) { pg8::Ffn3TailOrder S2{F.vcu}; pg8::gemm_phase<pg8::EpiSwiGLU, pg8::Ffn3TailOrder, true, true, 2>(F.lds, g, S2, E); }
        else convert_slot(F, ka, 5, (F.vcu - 192) * 8 + F.wave, (F.G - 192) * 8);
        return;
    }
    pg8::StaticOrder S; S.init(MT, NFF2, F.G, (int)blockIdx.x, 192);
    pg8::gemm_phase<pg8::EpiSwiGLU, pg8::StaticOrder, true, true, 3>(F.lds, g, S, E);
    if ((int)blockIdx.x >= 128) convert_slot(F, ka, fi == 0 ? 1 : fi + 2, ((int)blockIdx.x - 128) * 8 + F.wave, (F.G - 128) * 8);
}
__device__ __forceinline__ void gemm_ffn_out(Frame& F, int l, int sub, bool first_sub) {
    KA ka = get_ka();
    const int fi = l * 2 + (sub == 2 ? 1 : 0);
    bf16_t* X = (bf16_t*)(WS_ + WS_X);
    pg8::Gemm g{(const bf16_t*)(WS_ + WS_ACT), (const bf16_t*)(WS_ + WS_WOUT) + (size_t)fi * D * DFF, MT, D, DFF};
    pg8::StaticOrder S; S.init(MT, D, F.G, (int)blockIdx.x, 192);
    if (first_sub) {
        pg8::EpiResT<true> E{IN_(I_XP), IN_(I_XS) - (size_t)MCTX * D, X, MODS_ + (size_t)l * 3 * NMOD + (sub * 3 + 2) * D, 0.5f};
        pg8::gemm_phase<pg8::EpiResT<true>, pg8::StaticOrder, true, true, 3>(F.lds, g, S, E);
    } else {
        pg8::EpiResT<false> E{X, X, X, MODS_ + (size_t)l * 3 * NMOD + (sub * 3 + 2) * D, 0.5f};
        pg8::gemm_phase<pg8::EpiResT<false>, pg8::StaticOrder, true, true, 3>(F.lds, g, S, E);
    }
}
__device__ __forceinline__ void gemm_wo(Frame& F) {
    KA ka = get_ka();
    bf16_t* X = (bf16_t*)(WS_ + WS_X);
    pg8::Gemm g{(const bf16_t*)(WS_ + WS_O), (const bf16_t*)(WS_ + WS_WO), MT, D, D};
    pg8::StaticOrder S; S.init(MT, D, F.G, (int)blockIdx.x, 192);
    pg8::EpiResT<false> E{X, X, X, MODS_ + (size_t)(1 * 3 + 2) * D, 1.0f};
    pg8::gemm_phase<pg8::EpiResT<false>, pg8::StaticOrder, true, true, 3>(F.lds, g, S, E);
}
__device__ __forceinline__ void gemm_ga(Frame& F) {
    KA ka = get_ka();
    pg8::Gemm g{(const bf16_t*)(WS_ + WS_H), (const bf16_t*)(WS_ + WS_WA), MT, NA, D};
    pg8::StaticOrder S; S.init(MT, NA, F.G, (int)blockIdx.x, 192);
    pg8::EpiF32 E{(bf16_t*)(WS_ + WS_CQKV), NA};
    pg8::gemm_phase<pg8::EpiF32, pg8::StaticOrder, true, true, 3>(F.lds, g, S, E);
    if ((int)blockIdx.x >= 192) convert_slot(F, ka, 2, ((int)blockIdx.x - 192) * 8 + F.wave, (F.G - 192) * 8);
}
__device__ __forceinline__ void gemm_q(Frame& F) {
    KA ka = get_ka();
    pg8::Gemm g{(const bf16_t*)(WS_ + WS_CQ), (const bf16_t*)(WS_ + WS_WUQ), MT, NQ, QL};
    pg8::StaticOrder S; S.init(MT, NQ, F.G, (int)blockIdx.x);
    pg8::EpiQ E{(bf16_t*)(WS_ + WS_Q), ROPEC_, ROPES_};
    pg8::gemm_phase<pg8::EpiQ, pg8::StaticOrder, true, true>(F.lds, g, S, E);
}
__device__ __forceinline__ void gemm_kn(Frame& F) {
    KA ka = get_ka();
    pg8::Gemm g{(const bf16_t*)(WS_ + WS_CKV), (const bf16_t*)(WS_ + WS_WUK), KVR, D, KVL};
    pg8::StaticOrder S; S.init(KVR, D, F.G, (int)((blockIdx.x + 224) % F.G));
    pg8::EpiBf16 E{(bf16_t*)(WS_ + WS_KN), D};
    pg8::gemm_phase<pg8::EpiBf16, pg8::StaticOrder, true, true>(F.lds, g, S, E);
}
__device__ __forceinline__ void gemm_vt(Frame& F) {
    KA ka = get_ka();
    pg8::Gemm g{(const bf16_t*)(WS_ + WS_WUV), (const bf16_t*)(WS_ + WS_CKV), D, KVR, KVL};
    pg8::StaticOrder S; S.init(D, KVR, F.G, (int)((blockIdx.x + 208) % F.G));
    pg8::EpiBf16 E{(bf16_t*)(WS_ + WS_VT), KVR};
    pg8::gemm_phase<pg8::EpiBf16, pg8::StaticOrder, true, true>(F.lds, g, S, E);
}
__device__ __forceinline__ void gemm_glu(Frame& F) {
    KA ka = get_ka();
    bf16_t* X = (bf16_t*)(WS_ + WS_X);
    pg8::Gemm g{(const bf16_t*)(WS_ + WS_G), (const bf16_t*)(WS_ + WS_WGLU), MT, 4096, D};
    pg8::StaticOrder S; S.init(MT, 4096, F.G, (int)blockIdx.x, 192);
    pg8::EpiGLU E{X, X, MODS_ + (size_t)1 * 3 * NMOD + (1 * 3 + 2) * D};
    pg8::gemm_phase<pg8::EpiGLU, pg8::StaticOrder, true, true, 3>(F.lds, g, S, E);
}

__global__ void __launch_bounds__(512, 2) mk_fwd(Args args) {
    extern __shared__ __attribute__((aligned(16))) unsigned char lds_raw[];
    Frame F;
    F.lds = (LAS unsigned char*)lds_raw;
    F.tid = threadIdx.x; F.lane = F.tid & 63; F.wave = __builtin_amdgcn_readfirstlane(F.tid >> 6);
    F.G = gridDim.x; { const int bx = blockIdx.x; F.vcu = (F.G % 8 == 0) ? (bx % 8) * (F.G / 8) + bx / 8 : bx; }
    volatile LAS unsigned* MISC = (volatile LAS unsigned*)(F.lds + MISC_OFF);
    if (F.tid < 32) MISC[F.tid] = 0u;
    __syncthreads();
    const int lo = args.ph_lo, hi = args.ph_hi; const bool use_bar = args.use_bar != 0;
    XcdBarrier bar; bar.bar = (unsigned*)(args.ws + WS_CTL) + 1024; bar.x = 0; bar.st = nullptr;
    if (use_bar) bar = xcd_barrier_post((unsigned*)(args.ws + WS_CTL) + 1024, MISC + 8);
#define IN(k) (lo <= (k) && (k) < hi)
#define SEAM(k) do { if ((k) + 1 < hi) { if (use_bar) xcd_barrier(bar); else __syncthreads(); } } while (0)
#ifndef REP_PH
#define REP_PH -1
#define REP_N 0
#endif
#define PHASE(k, body) do { if (IN(k)) { for (int r_ = 0; r_ < ((k) == REP_PH ? REP_N : 0); ++r_) { body; if (use_bar) xcd_barrier(bar); else __syncthreads(); } body; SEAM(k); } } while (0)
    PHASE(0, phase_prologue(F));
    PHASE(1, phase_norm(F, 0, 0, true));
    PHASE(2, gemm_ffn_in(F, 0));
    PHASE(3, gemm_ffn_out(F, 0, 0, true));
    PHASE(4, phase_norm(F, 0, 1, false));
    PHASE(5, gemm_ga(F));
    PHASE(6, phase_mla_norm(F));
    PHASE(7, { gemm_q(F); gemm_kn(F); gemm_vt(F); });
    PHASE(8, phase_attn(F));
    PHASE(9, gemm_wo(F));
    PHASE(10, phase_norm(F, 0, 2, false));
    PHASE(11, gemm_ffn_in(F, 1));
    PHASE(12, gemm_ffn_out(F, 0, 2, false));
    PHASE(13, phase_norm(F, 1, 0, false));
    PHASE(14, gemm_ffn_in(F, 2));
    PHASE(15, gemm_ffn_out(F, 1, 0, false));
    PHASE(16, phase_norm(F, 1, 1, false));
    PHASE(17, phase_s5(F));
    PHASE(18, gemm_glu(F));
    PHASE(19, phase_norm(F, 1, 2, false));
    PHASE(20, gemm_ffn_in(F, 3));
    PHASE(21, gemm_ffn_out(F, 1, 2, false));
    PHASE(22, phase_final(F));
#undef IN
#undef SEAM
#undef PHASE
}

extern "C" void kernel_launch(void* const* d_in, const int* in_sizes, int n_in, void* d_out, int out_size, void* d_ws, size_t ws_size, hipStream_t stream) {
    static int grid = 0;
    if (grid == 0) {
        if (n_in != 30 || ws_size < WS_END) { fprintf(stderr, "kernel_launch: unexpected n_in %d / ws_size %zu\n", n_in, ws_size); grid = -1; return; }
        int dev = 0, cus = 0, per_cu = 0;
        if (hipGetDevice(&dev) != hipSuccess || hipDeviceGetAttribute(&cus, hipDeviceAttributeMultiprocessorCount, dev) != hipSuccess) { grid = -1; return; }
        if (hipFuncSetAttribute((const void*)mk_fwd, hipFuncAttributeMaxDynamicSharedMemorySize, LDS_BYTES) != hipSuccess) { fprintf(stderr, "kernel_launch: hipFuncSetAttribute failed\n"); grid = -1; return; }
        if (hipOccupancyMaxActiveBlocksPerMultiprocessor(&per_cu, (const void*)mk_fwd, 512, LDS_BYTES) != hipSuccess || per_cu < 1) { fprintf(stderr, "kernel_launch: occupancy query says %d blocks per CU\n", per_cu); per_cu = 1; }
        (void)hipGetLastError();
        grid = cus;
    }
    if (grid < 0) return;
    (void)hipMemsetAsync((char*)d_ws + WS_CTL, 0, CTL_ZERO_BYTES, stream);
    Args a{};
    for (int i = 0; i < 30; ++i) a.in[i] = (const float*)d_in[i];
    a.out = (float*)d_out; a.ws = (unsigned char*)d_ws;
#if MK_PER_PHASE
    for (int ph = 0; ph < NPH; ++ph) {
        a.ph_lo = ph; a.ph_hi = ph + 1; a.use_bar = 0;
        hipLaunchKernelGGL(mk_fwd, dim3(grid), dim3(512), LDS_BYTES, stream, a);
    }
#else
    a.ph_lo = 0; a.ph_hi = NPH; a.use_bar = 1;
    void* kargs[] = {&a};
    hipError_t e = hipLaunchCooperativeKernel((const void*)mk_fwd, dim3(grid), dim3(512), kargs, LDS_BYTES, stream);
    if (e != hipSuccess) fprintf(stderr, "kernel_launch: cooperative launch failed: %s (grid %d)\n", hipGetErrorString(e), grid);
#endif
}
```
